# Optimizing an MI355X kernel written in HIP

```python
import jax, jax.numpy as jnp
from jax import lax
import numpy as np

D_MODEL = 1024
BATCH = 2
SEQ = 8192
DEPTH = 1
DEC_BATCH = 128
DEC_SEQ = 4
PAST_LEN = 8192
PAGE_SIZE = 128

MIX_W = D_MODEL
M_WIDTH = MIX_W // 2
M_HEADS = 4
M_DV = M_WIDTH // M_HEADS
M_DK = M_DV // 2
QK_W = 2 * M_HEADS * M_DK
CONV_W = 4
CHUNK = 128
A_WIDTH = MIX_W - M_WIDTH
A_HEADS = 8
A_HD = A_WIDTH // A_HEADS
A_KV = 2
A_GROUP = A_HEADS // A_KV
KV_W = A_KV * A_HD
WINDOW = 128
D_FF = 4 * D_MODEL
P_DIM = 256
PROJ_W = QK_W + 2 * M_WIDTH + 2 * M_HEADS + A_WIDTH + 2 * KV_W
EPS = 1e-6

kernel_name = "hymba_mlstm_swa_sink_decode_step"

F32 = jnp.float32


def rms_norm(x, g):
    xf = x.astype(F32)
    y = xf * lax.rsqrt(jnp.mean(xf * xf, axis=-1, keepdims=True) + EPS)
    return (y * g.astype(F32)).astype(x.dtype)


def split_projection(z):
    sizes = (QK_W, M_WIDTH, M_WIDTH, 2 * M_HEADS, A_WIDTH, KV_W, KV_W)
    cuts = [int(c) for c in np.cumsum(sizes)[:-1]]
    return jnp.split(z, cuts, axis=-1)


def short_conv(u, buf, w):
    T = u.shape[1]
    up = jnp.concatenate([buf.astype(u.dtype), u], axis=1)
    out = sum(w[j] * up[:, j:j + T] for j in range(CONV_W))
    return jax.nn.silu(out), up[:, T:]


def mlstm_heads(qk, v, gates, b_gates):
    B, T, _ = qk.shape
    q, k = jnp.split(qk, 2, axis=-1)
    q = q.reshape(B, T, M_HEADS, M_DK).transpose(0, 2, 1, 3).astype(F32) * (M_DK ** -0.5)
    k = k.reshape(B, T, M_HEADS, M_DK).transpose(0, 2, 1, 3).astype(F32)
    v = v.reshape(B, T, M_HEADS, M_DV).transpose(0, 2, 1, 3).astype(F32)
    g = gates.astype(F32) + b_gates.astype(F32)
    ig = g[..., :M_HEADS].transpose(0, 2, 1)
    lf = jax.nn.log_sigmoid(g[..., M_HEADS:]).transpose(0, 2, 1)
    return q, k, v, ig, lf


def mlstm_chunk(state, blk):
    c_prev, n_prev, m_prev = state
    q, k, v, ig, lf = blk
    L = q.shape[2]
    b = jnp.cumsum(lf, axis=-1)
    causal = jnp.tril(jnp.ones((L, L), dtype=bool))
    log_d = jnp.where(causal, b[..., :, None] - b[..., None, :] + ig[..., None, :], -jnp.inf)
    log_inter = b + m_prev[..., None]
    m_t = jnp.maximum(log_inter, jnp.max(log_d, axis=-1))
    w_intra = jnp.exp(log_d - m_t[..., None])
    w_inter = jnp.exp(log_inter - m_t)
    s = jnp.einsum('bhtd,bhsd->bhts', q, k) * w_intra
    num = jnp.einsum('bhts,bhsv->bhtv', s, v) + w_inter[..., None] * jnp.einsum('bhtd,bhdv->bhtv', q, c_prev)
    den = jnp.sum(s, axis=-1) + w_inter * jnp.einsum('bhtd,bhd->bht', q, n_prev)
    h = num / jnp.maximum(jnp.abs(den), jnp.exp(-m_t))[..., None]
    b_last = b[..., -1]
    log_w = b_last[..., None] - b + ig
    m_new = jnp.maximum(b_last + m_prev, jnp.max(log_w, axis=-1))
    w_k = jnp.exp(log_w - m_new[..., None])
    decay = jnp.exp(b_last + m_prev - m_new)
    c_new = decay[..., None, None] * c_prev + jnp.einsum('bhs,bhsd,bhsv->bhdv', w_k, k, v)
    n_new = decay[..., None] * n_prev + jnp.einsum('bhs,bhsd->bhd', w_k, k)
    return (c_new, n_new, m_new), h


def mlstm_prompt(q, k, v, ig, lf):
    B, H, T, _ = q.shape
    nc = T // CHUNK

    def to_chunks(a):
        return jnp.moveaxis(a.reshape((B, H, nc, CHUNK) + a.shape[3:]), 2, 0)

    init = (jnp.zeros((B, H, M_DK, M_DV), F32), jnp.zeros((B, H, M_DK), F32), jnp.zeros((B, H), F32))
    final, h = lax.scan(mlstm_chunk, init, tuple(to_chunks(a) for a in (q, k, v, ig, lf)))
    h = jnp.moveaxis(h, 0, 2).reshape(B, H, T, M_DV)
    return final, h


def mlstm_output(h, o, g):
    B, H, T, _ = h.shape
    hn = h * lax.rsqrt(jnp.mean(h * h, axis=-1, keepdims=True) + EPS)
    hn = hn * g.astype(F32).reshape(M_HEADS, 1, M_DV)
    hn = hn.transpose(0, 2, 1, 3).reshape(B, T, M_WIDTH)
    return (jax.nn.sigmoid(o.astype(F32)) * hn).astype(o.dtype)


def alibi_slopes():
    return jnp.exp2(-8.0 * jnp.arange(1, A_HEADS + 1, dtype=F32) / A_HEADS).reshape(A_KV, A_GROUP)


def sink_softmax(scores, sinks):
    s = sinks.astype(F32).reshape(A_KV, A_GROUP)[:, :, None, None]
    m = jnp.maximum(jnp.max(scores, axis=-1, keepdims=True), s)
    e = jnp.exp(scores - m)
    return e / (jnp.sum(e, axis=-1, keepdims=True) + jnp.exp(s - m))


def swa_prompt(q, k, v, sinks):
    B, T = q.shape[:2]
    nb = T // WINDOW
    qb = q.reshape(B, nb, WINDOW, A_KV, A_GROUP, A_HD).astype(F32)
    kb = k.reshape(B, nb, WINDOW, A_KV, A_HD).astype(F32)
    vb = v.reshape(B, nb, WINDOW, A_KV, A_HD).astype(F32)
    pad = ((0, 0), (1, 0), (0, 0), (0, 0), (0, 0))
    kk = jnp.concatenate([jnp.pad(kb, pad)[:, :-1], kb], axis=2)
    vv = jnp.concatenate([jnp.pad(vb, pad)[:, :-1], vb], axis=2)
    qi = jnp.arange(WINDOW)[:, None] + WINDOW
    si = jnp.arange(2 * WINDOW)[None, :]
    d = qi - si
    band = (d >= 0) & (d <= WINDOW)
    not_first = jnp.arange(nb)[:, None, None] > 0
    valid = band[None] & (not_first | (si >= WINDOW)[None])
    scores = jnp.einsum('bnqkgd,bnskd->bnkgqs', qb, kk) * (A_HD ** -0.5)
    scores = scores - alibi_slopes()[:, :, None, None] * d.astype(F32)
    scores = jnp.where(valid[None, :, None, None], scores, -jnp.inf)
    p = sink_softmax(scores, sinks)
    out = jnp.einsum('bnkgqs,bnskd->bnqkgd', p, vv)
    return out.reshape(B, T, A_WIDTH)


def swa_sample(q, k, v, k_buf, v_buf, sinks):
    B, T = q.shape[:2]
    k_all = jnp.concatenate([k_buf.astype(k.dtype), k], axis=1)
    v_all = jnp.concatenate([v_buf.astype(v.dtype), v], axis=1)
    qi = jnp.arange(T)[:, None] + WINDOW
    si = jnp.arange(WINDOW + T)[None, :]
    d = qi - si
    valid = (d >= 0) & (d <= WINDOW)
    qh = q.reshape(B, T, A_KV, A_GROUP, A_HD).astype(F32)
    scores = jnp.einsum('bqkgd,bskd->bkgqs', qh, k_all.astype(F32)) * (A_HD ** -0.5)
    scores = scores - alibi_slopes()[:, :, None, None] * d.astype(F32)
    scores = jnp.where(valid, scores, -jnp.inf)
    p = sink_softmax(scores, sinks)
    out = jnp.einsum('bkgqs,bskd->bqkgd', p, v_all.astype(F32)).reshape(B, T, A_WIDTH)
    return out, k_all[:, T:], v_all[:, T:]


def decoder_layer(x, p, lp, state):
    B, T, _ = x.shape
    xn = rms_norm(x, lp['norm_mix_pre'])
    qk_raw, v_m, o_m, gates, q_a, k_a, v_a = split_projection(xn @ lp['w_in'])
    q_a = q_a.reshape(B, T, A_HEADS, A_HD)
    k_a = k_a.reshape(B, T, A_KV, A_HD)
    v_a = v_a.reshape(B, T, A_KV, A_HD)
    if state is None:
        conv_buf = jnp.zeros((B, CONV_W - 1, QK_W), x.dtype)
    else:
        c0, n0, m0, conv_buf, k_buf, v_buf = state
    qk, conv_new = short_conv(qk_raw, conv_buf, lp['conv_w'])
    q, k, v, ig, lf = mlstm_heads(qk, v_m, gates, lp['b_gates'])
    if state is None:
        (c_new, n_new, m_new), h = mlstm_prompt(q, k, v, ig, lf)
        att = swa_prompt(q_a, k_a, v_a, lp['attn_sinks'])
        k_new, v_new = k_a[:, -WINDOW:], v_a[:, -WINDOW:]
    else:
        init = (c0.astype(F32), n0.astype(F32), m0.astype(F32))
        (c_new, n_new, m_new), h = mlstm_chunk(init, (q, k, v, ig, lf))
        att, k_new, v_new = swa_sample(q_a, k_a, v_a, k_buf, v_buf, lp['attn_sinks'])
    y_m = mlstm_output(h, o_m, lp['mlstm_norm'])
    y_a = rms_norm(att.astype(x.dtype), lp['attn_norm'])
    mix = jnp.concatenate([y_m, y_a], axis=-1) @ lp['w_out']
    x = x + rms_norm(mix, lp['norm_mix_post'])
    u = rms_norm(x, lp['norm_ffn_pre'])
    f = jnp.square(jax.nn.relu(u @ lp['w_up'])) @ lp['w_down']
    x = x + rms_norm(f, lp['norm_ffn_post'])
    x = x + jax.nn.sigmoid(x @ lp['w_pgate']) * (p @ lp['w_pproj'])
    return x, (c_new, n_new, m_new, conv_new, k_new, v_new)


def setup_inputs(seed: int = 0) -> dict:
    key = jax.random.key(seed)
    ks = jax.random.split(key, 26)

    def nrm(k, shape, s):
        return jax.random.normal(k, shape, F32) * s

    def gain(k, width):
        return 1.0 + 0.1 * jax.random.normal(k, (DEPTH, width), F32)

    b_i = nrm(ks[0], (DEPTH, M_HEADS), 0.1)
    b_f = 3.0 + nrm(ks[1], (DEPTH, M_HEADS), 0.5)
    return {
        'x_prompt': nrm(ks[2], (BATCH, SEQ, D_MODEL), 1.0),
        'x_sample': nrm(ks[3], (DEC_BATCH, DEC_SEQ, D_MODEL), 1.0),
        'p_prompt': nrm(ks[4], (DEPTH, BATCH, SEQ, P_DIM), 1.0),
        'p_sample': nrm(ks[5], (DEPTH, DEC_BATCH, DEC_SEQ, P_DIM), 1.0),
        'state_mlstm_c': nrm(ks[6], (DEPTH, DEC_BATCH, M_HEADS, M_DK, M_DV), 0.5),
        'state_mlstm_n': nrm(ks[7], (DEPTH, DEC_BATCH, M_HEADS, M_DK), 1.0),
        'state_mlstm_m': nrm(ks[8], (DEPTH, DEC_BATCH, M_HEADS), 1.0),
        'state_mlstm_conv': nrm(ks[9], (DEPTH, DEC_BATCH, CONV_W - 1, QK_W), 1.0),
        'cache_swa_k': nrm(ks[10], (DEPTH, DEC_BATCH, WINDOW, A_KV, A_HD), 1.0),
        'cache_swa_v': nrm(ks[11], (DEPTH, DEC_BATCH, WINDOW, A_KV, A_HD), 1.0),
        'norm_mix_pre': gain(ks[12], D_MODEL),
        'w_in': nrm(ks[13], (DEPTH, D_MODEL, PROJ_W), D_MODEL ** -0.5),
        'b_gates': jnp.concatenate([b_i, b_f], axis=-1),
        'conv_w': nrm(ks[14], (DEPTH, CONV_W, QK_W), CONV_W ** -0.5),
        'mlstm_norm': gain(ks[15], M_WIDTH),
        'attn_sinks': nrm(ks[16], (DEPTH, A_HEADS), 1.0),
        'attn_norm': gain(ks[17], A_WIDTH),
        'w_out': nrm(ks[18], (DEPTH, MIX_W, D_MODEL), MIX_W ** -0.5),
        'norm_mix_post': gain(ks[19], D_MODEL),
        'norm_ffn_pre': gain(ks[20], D_MODEL),
        'w_up': nrm(ks[21], (DEPTH, D_MODEL, D_FF), D_MODEL ** -0.5),
        'w_down': nrm(ks[22], (DEPTH, D_FF, D_MODEL), D_FF ** -0.5),
        'norm_ffn_post': gain(ks[23], D_MODEL),
        'w_pgate': nrm(ks[24], (DEPTH, D_MODEL, D_MODEL), D_MODEL ** -0.5),
        'w_pproj': nrm(ks[25], (DEPTH, P_DIM, D_MODEL), P_DIM ** -0.5),
    }


def reference(x_prompt, x_sample, p_prompt, p_sample, state_mlstm_c, state_mlstm_n, state_mlstm_m,
              state_mlstm_conv, cache_swa_k, cache_swa_v, norm_mix_pre, w_in, b_gates, conv_w,
              mlstm_norm, attn_sinks, attn_norm, w_out, norm_mix_post, norm_ffn_pre, w_up, w_down,
              norm_ffn_post, w_pgate, w_pproj):
    hp, hs = x_prompt, x_sample
    new_p = [[] for _ in range(6)]
    new_s = [[] for _ in range(6)]
    for i in range(DEPTH):
        lp = {
            'norm_mix_pre': norm_mix_pre[i], 'w_in': w_in[i], 'b_gates': b_gates[i],
            'conv_w': conv_w[i], 'mlstm_norm': mlstm_norm[i], 'attn_sinks': attn_sinks[i],
            'attn_norm': attn_norm[i], 'w_out': w_out[i], 'norm_mix_post': norm_mix_post[i],
            'norm_ffn_pre': norm_ffn_pre[i], 'w_up': w_up[i], 'w_down': w_down[i],
            'norm_ffn_post': norm_ffn_post[i], 'w_pgate': w_pgate[i], 'w_pproj': w_pproj[i],
        }
        hp, sp = decoder_layer(hp, p_prompt[i], lp, None)
        st = (state_mlstm_c[i], state_mlstm_n[i], state_mlstm_m[i], state_mlstm_conv[i],
              cache_swa_k[i], cache_swa_v[i])
        hs, ss = decoder_layer(hs, p_sample[i], lp, st)
        for lst, a in zip(new_p, sp):
            lst.append(a)
        for lst, a in zip(new_s, ss):
            lst.append(a)
    c_p, n_p, m_p, conv_p, k_p, v_p = [jnp.stack(l) for l in new_p]
    c_s, n_s, m_s, conv_s, k_s, v_s = [jnp.stack(l) for l in new_s]
    return (hp, hs, c_p, n_p, m_p, conv_p, k_p, v_p, c_s, n_s, m_s, conv_s, k_s, v_s)
```

```cpp
#include <hip/hip_runtime.h>
#include <hip/hip_cooperative_groups.h>
#include <cstdio>
#include <cstdint>
namespace cg = cooperative_groups;
namespace pg8 {
#define PG8_LAS __attribute__((address_space(3)))
typedef unsigned short bf16_t;
typedef short bf16x8 __attribute__((ext_vector_type(8)));
typedef float f32x4 __attribute__((ext_vector_type(4)));
typedef unsigned u32x4 __attribute__((ext_vector_type(4)));
constexpr int BM = 256, BK = 64, HALF = 128, HTB = HALF * BK * 2  , STAGE_BYTES = 8 * HTB, NXCD = 8, WGM = 8;

__host__ __device__ __forceinline__ int lds_byte(int r, int c) { const int st = (r >> 4) * 2 + (c >> 5), rr = r & 15, cc = c & 31, ob = rr * 64 + cc * 2; return st * 1024 + (ob ^ (((ob >> 9) & 1) << 5)); }
__host__ __device__ __forceinline__ void stage_rc(int b, int& R, int& C) { const int st = b / 1024, sb = b % 1024, swz = sb ^ (((sb >> 9) & 1) << 5); R = (st >> 1) * 16 + swz / 64; C = (st & 1) * 32 + (swz % 64) / 2; }
__host__ __device__ __forceinline__ int perm32(int rho) { const int n = rho >> 4, i = rho & 15; return 8 * (i >> 2) + 4 * n + (i & 3); }

struct Unit { int pm, pn; };
struct Gemm { const bf16_t* A; const bf16_t* Bt; int M, N, K; };

struct StaticOrder {
    int nM, nN, nwg, G, c;
    __host__ __device__ void init(int M, int N, int G_, int c_) { nM = M / BM; nN = N / BM; nwg = nM * nN; G = G_; c = c_; }
    __host__ __device__ bool next(int i, Unit& u) const {
        const long L = (long)i * G + c; if (L >= nwg) return false;
        int wgid = (int)L; { const int q = nwg / NXCD, r = nwg % NXCD, xcd = wgid % NXCD, off = wgid / NXCD; wgid = (xcd < r ? xcd * (q + 1) : r * (q + 1) + (xcd - r) * q) + off; }
        const int nig = WGM * nN, gid = wgid / nig, fm = gid * WGM, gsz = (nM - fm) < WGM ? (nM - fm) : WGM;
        u.pm = fm + ((wgid % nig) % gsz); u.pn = (wgid % nig) / gsz; return true;
    }
    __device__ __forceinline__ void a_ready(const Unit&) const {}
    __device__ __forceinline__ void done(const Unit&) const {}
};

__device__ __forceinline__ unsigned cvt_pk_bf16(float lo, float hi) { unsigned r; asm volatile("v_cvt_pk_bf16_f32 %0, %1, %2" : "=v"(r) : "v"(lo), "v"(hi)); return r; }
template <int ACT> struct EpiBf16 {
    static constexpr bool PERM = true, AFTER_DRAIN = false;
    bf16_t* O; int ldc;
    __device__ __forceinline__ void operator()(const f32x4 (&acc)[2][2][4][2], const Unit& u, int wr, int wc, int fr, int fq) const {
        const int row0 = u.pm * BM + wr * 64 + fr; const int col0 = u.pn * BM + wc * 32 + 8 * fq;
#pragma unroll
        for (int ai = 0; ai < 2; ++ai)
#pragma unroll
            for (int m = 0; m < 4; ++m) { bf16_t* rowp = O + (size_t)(row0 + ai * HALF + m * 16) * ldc + col0;
#pragma unroll
                for (int bj = 0; bj < 2; ++bj) { f32x4 v0 = acc[ai][bj][m][0], v1 = acc[ai][bj][m][1];
                    if (ACT == 2) {
#pragma unroll
                        for (int e = 0; e < 4; ++e) { float a = v0[e] > 0.f ? v0[e] : 0.f; v0[e] = a * a; float b = v1[e] > 0.f ? v1[e] : 0.f; v1[e] = b * b; } }
                    u32x4 w; w.x = cvt_pk_bf16(v0[0], v0[1]); w.y = cvt_pk_bf16(v0[2], v0[3]); w.z = cvt_pk_bf16(v1[0], v1[1]); w.w = cvt_pk_bf16(v1[2], v1[3]);
                    *(u32x4*)(rowp + bj * HALF) = w; } }
    }
};
struct EpiFinal {
    static constexpr bool PERM = true, AFTER_DRAIN = false;
    float* out; const bf16_t* PP; const bf16_t* X2; int ldc;
    __device__ __forceinline__ void operator()(const f32x4 (&acc)[2][2][4][2], const Unit& u, int wr, int wc, int fr, int fq) const {
        const int col0 = u.pn * BM + wc * 32 + 8 * fq;
        u32x4 xs[2][2], pw[2][2];
#define EF_LOAD(gi, buf) do { const int ai_ = (gi) >> 2, m_ = (gi) & 3; const size_t off_ = (size_t)(u.pm * BM + ai_ * HALF + wr * 64 + m_ * 16 + fr) * ldc + col0; \
        _Pragma("unroll") for (int q = 0; q < 2; ++q) { xs[buf][q] = *(const u32x4*)(X2 + off_ + q * HALF); pw[buf][q] = *(const u32x4*)(PP + off_ + q * HALF); } } while (0)
        EF_LOAD(0, 0);
#pragma unroll
        for (int gi = 0; gi < 8; ++gi) {
            if (gi + 1 < 8) EF_LOAD(gi + 1, (gi + 1) & 1);
            asm volatile("" ::: "memory");
            const int ai = gi >> 2, m = gi & 3; const size_t off = (size_t)(u.pm * BM + ai * HALF + wr * 64 + m * 16 + fr) * ldc + col0;
#pragma unroll
            for (int bj = 0; bj < 2; ++bj) { const u32x4 w = pw[gi & 1][bj], xw = xs[gi & 1][bj];
#pragma unroll
                for (int n = 0; n < 2; ++n) { const f32x4 a = acc[ai][bj][m][n]; const unsigned wa = n ? w.z : w.x, wb = n ? w.w : w.y, xa = n ? xw.z : xw.x, xb = n ? xw.w : xw.y;
                    f32x4 p, xf; p[0] = __uint_as_float(wa << 16); p[1] = __uint_as_float(wa & 0xffff0000u); p[2] = __uint_as_float(wb << 16); p[3] = __uint_as_float(wb & 0xffff0000u);
                    xf[0] = __uint_as_float(xa << 16); xf[1] = __uint_as_float(xa & 0xffff0000u); xf[2] = __uint_as_float(xb << 16); xf[3] = __uint_as_float(xb & 0xffff0000u);
                    f32x4 res;
#pragma unroll
                    for (int e = 0; e < 4; ++e) res[e] = xf[e] + p[e] * __builtin_amdgcn_rcpf(1.f + __expf(-a[e]));
                    *(f32x4*)(out + off + bj * HALF + n * 4) = res; } }
        }
#undef EF_LOAD
    }
};
struct RowSumSq {
    float* xbuf;
    unsigned* cnt;
    __device__ __forceinline__ void run(const f32x4 (&v)[2][2][4][2], const Unit& u, int wr, int wc, int fr, int fq, PG8_LAS unsigned char* lds, int wid, int lane) const {
        PG8_LAS float* P = (PG8_LAS float*)lds;
        PG8_LAS float* S = (PG8_LAS float*)(lds + 4096);
#pragma unroll
        for (int ai = 0; ai < 2; ++ai)
#pragma unroll
            for (int m = 0; m < 4; ++m) { float s = 0.f;
#pragma unroll
                for (int bj = 0; bj < 2; ++bj)
#pragma unroll
                    for (int n = 0; n < 2; ++n) { const f32x4 x = v[ai][bj][m][n]; s += (x[0] * x[0] + x[1] * x[1]) + (x[2] * x[2] + x[3] * x[3]); }
                s += __shfl_xor(s, 16); s += __shfl_xor(s, 32);
                if (fq == 0) P[(ai * HALF + wr * 64 + m * 16 + fr) * 4 + wc] = s; }
        asm volatile("s_waitcnt lgkmcnt(0)" ::: "memory"); __builtin_amdgcn_s_barrier(); asm volatile("" ::: "memory");
        const int row = wid * 32 + (lane & 31);
        if (lane < 32) { const float t = (P[row * 4 + 0] + P[row * 4 + 1]) + (P[row * 4 + 2] + P[row * 4 + 3]);
            __hip_atomic_store(xbuf + ((size_t)(u.pm * BM + row) * 4 + u.pn), t, __ATOMIC_RELAXED, __HIP_MEMORY_SCOPE_AGENT); }
        asm volatile("s_waitcnt vmcnt(0)" ::: "memory");
        if (lane == 0) __hip_atomic_fetch_add(cnt + 64 * u.pm, 1u, __ATOMIC_RELAXED, __HIP_MEMORY_SCOPE_AGENT);
        if (wid == 0) { unsigned sp = 0u;
            for (;;) { if ((unsigned)__builtin_amdgcn_readfirstlane(__hip_atomic_load(cnt + 64 * u.pm, __ATOMIC_RELAXED, __HIP_MEMORY_SCOPE_AGENT)) >= 32u) break;
                if (++sp > (1u << 21)) break;
                __builtin_amdgcn_s_sleep(2); }
            __builtin_amdgcn_fence(__ATOMIC_ACQUIRE, "agent"); }
        asm volatile("s_waitcnt vmcnt(0) lgkmcnt(0)" ::: "memory"); __builtin_amdgcn_s_barrier(); asm volatile("" ::: "memory");
        if (lane < 32) { const float* slot = xbuf + (size_t)(u.pm * BM + row) * 4;
            const float t0 = __hip_atomic_load(slot + 0, __ATOMIC_RELAXED, __HIP_MEMORY_SCOPE_AGENT), t1 = __hip_atomic_load(slot + 1, __ATOMIC_RELAXED, __HIP_MEMORY_SCOPE_AGENT);
            const float t2 = __hip_atomic_load(slot + 2, __ATOMIC_RELAXED, __HIP_MEMORY_SCOPE_AGENT), t3 = __hip_atomic_load(slot + 3, __ATOMIC_RELAXED, __HIP_MEMORY_SCOPE_AGENT);
            S[row] = (t0 + t1) + (t2 + t3); }
        asm volatile("s_waitcnt lgkmcnt(0)" ::: "memory"); __builtin_amdgcn_s_barrier(); asm volatile("" ::: "memory");
    }
};
struct EpiMixNorm {
    static constexpr bool PERM = true, AFTER_DRAIN = true;
    const float* gpost; const float* gffn; bf16_t* X1; bf16_t* U; int ldc; float eps; RowSumSq st1, st2;
    __device__ __forceinline__ void fused(f32x4 (&acc)[2][2][4][2], const Unit& u, int wr, int wc, int fr, int fq, PG8_LAS unsigned char* lds, int wid, int lane) const {
        const PG8_LAS float* S = (const PG8_LAS float*)(lds + 4096);
        const int col0 = u.pn * BM + wc * 32 + 8 * fq;
        st1.run(acc, u, wr, wc, fr, fq, lds, wid, lane);
        f32x4 gv[2][2];
#pragma unroll
        for (int bj = 0; bj < 2; ++bj)
#pragma unroll
            for (int n = 0; n < 2; ++n) gv[bj][n] = *(const f32x4*)(gpost + col0 + bj * HALF + n * 4);
#pragma unroll
        for (int ai = 0; ai < 2; ++ai)
#pragma unroll
            for (int m = 0; m < 4; ++m) { const int r = ai * HALF + wr * 64 + m * 16 + fr; const float rs = 1.0f / sqrtf(S[r] * (1.0f / 1024.0f) + eps); const size_t off = (size_t)(u.pm * BM + r) * ldc + col0;
#pragma unroll
                for (int bj = 0; bj < 2; ++bj) { const u32x4 xw = *(const u32x4*)(X1 + off + bj * HALF);
                    f32x4 x0, x1; x0[0] = __uint_as_float(xw.x << 16); x0[1] = __uint_as_float(xw.x & 0xffff0000u); x0[2] = __uint_as_float(xw.y << 16); x0[3] = __uint_as_float(xw.y & 0xffff0000u);
                    x1[0] = __uint_as_float(xw.z << 16); x1[1] = __uint_as_float(xw.z & 0xffff0000u); x1[2] = __uint_as_float(xw.w << 16); x1[3] = __uint_as_float(xw.w & 0xffff0000u);
                    acc[ai][bj][m][0] = x0 + acc[ai][bj][m][0] * gv[bj][0] * rs; acc[ai][bj][m][1] = x1 + acc[ai][bj][m][1] * gv[bj][1] * rs; }
                asm volatile("" : "+v"(acc[ai][0][m][0]), "+v"(acc[ai][0][m][1]), "+v"(acc[ai][1][m][0]), "+v"(acc[ai][1][m][1]));
                if (m & 1) asm volatile("" ::: "memory"); }
        st2.run(acc, u, wr, wc, fr, fq, lds, wid, lane);
#pragma unroll
        for (int bj = 0; bj < 2; ++bj)
#pragma unroll
            for (int n = 0; n < 2; ++n) gv[bj][n] = *(const f32x4*)(gffn + col0 + bj * HALF + n * 4);
#pragma unroll
        for (int ai = 0; ai < 2; ++ai)
#pragma unroll
            for (int m = 0; m < 4; ++m) { const int r = ai * HALF + wr * 64 + m * 16 + fr; const float rs = 1.0f / sqrtf(S[r] * (1.0f / 1024.0f) + eps); const size_t off = (size_t)(u.pm * BM + r) * ldc + col0;
#pragma unroll
                for (int bj = 0; bj < 2; ++bj) { const f32x4 a0 = acc[ai][bj][m][0], a1 = acc[ai][bj][m][1]; const f32x4 o0 = a0 * gv[bj][0] * rs, o1 = a1 * gv[bj][1] * rs; const size_t oo = off + bj * HALF;
                    u32x4 w1; w1.x = cvt_pk_bf16(a0[0], a0[1]); w1.y = cvt_pk_bf16(a0[2], a0[3]); w1.z = cvt_pk_bf16(a1[0], a1[1]); w1.w = cvt_pk_bf16(a1[2], a1[3]); *(u32x4*)(X1 + oo) = w1;
                    u32x4 w2; w2.x = cvt_pk_bf16(o0[0], o0[1]); w2.y = cvt_pk_bf16(o0[2], o0[3]); w2.z = cvt_pk_bf16(o1[0], o1[1]); w2.w = cvt_pk_bf16(o1[2], o1[3]); *(u32x4*)(U + oo) = w2; } }
    }
};
struct EpiFfnNorm {
    static constexpr bool PERM = true, AFTER_DRAIN = true;
    const bf16_t* X1; const float* g; bf16_t* X2; int ldc; float eps; RowSumSq st;
    __device__ __forceinline__ void fused(f32x4 (&acc)[2][2][4][2], const Unit& u, int wr, int wc, int fr, int fq, PG8_LAS unsigned char* lds, int wid, int lane) const {
        const PG8_LAS float* S = (const PG8_LAS float*)(lds + 4096);
        const int col0 = u.pn * BM + wc * 32 + 8 * fq;
        st.run(acc, u, wr, wc, fr, fq, lds, wid, lane);
        f32x4 gv[2][2];
#pragma unroll
        for (int bj = 0; bj < 2; ++bj)
#pragma unroll
            for (int n = 0; n < 2; ++n) gv[bj][n] = *(const f32x4*)(g + col0 + bj * HALF + n * 4);
#pragma unroll
        for (int ai = 0; ai < 2; ++ai)
#pragma unroll
            for (int m = 0; m < 4; ++m) { const int r = ai * HALF + wr * 64 + m * 16 + fr; const float rs = 1.0f / sqrtf(S[r] * (1.0f / 1024.0f) + eps); const size_t off = (size_t)(u.pm * BM + r) * ldc + col0;
#pragma unroll
                for (int bj = 0; bj < 2; ++bj) { const size_t oo = off + bj * HALF; const u32x4 xw = *(const u32x4*)(X1 + oo);
                    f32x4 x0, x1; x0[0] = __uint_as_float(xw.x << 16); x0[1] = __uint_as_float(xw.x & 0xffff0000u); x0[2] = __uint_as_float(xw.y << 16); x0[3] = __uint_as_float(xw.y & 0xffff0000u);
                    x1[0] = __uint_as_float(xw.z << 16); x1[1] = __uint_as_float(xw.z & 0xffff0000u); x1[2] = __uint_as_float(xw.w << 16); x1[3] = __uint_as_float(xw.w & 0xffff0000u);
                    const f32x4 o0 = x0 + acc[ai][bj][m][0] * gv[bj][0] * rs, o1 = x1 + acc[ai][bj][m][1] * gv[bj][1] * rs;
                    u32x4 w; w.x = cvt_pk_bf16(o0[0], o0[1]); w.y = cvt_pk_bf16(o0[2], o0[3]); w.z = cvt_pk_bf16(o1[0], o1[1]); w.w = cvt_pk_bf16(o1[2], o1[3]); *(u32x4*)(X2 + oo) = w; }
                if (m & 1) asm volatile("" ::: "memory"); }
    }
};
template <class Epi, class Sched, bool ALIGN_EPI = false, bool SP2 = false>
__device__ __forceinline__ void gemm_phase(PG8_LAS unsigned char* lds, const Gemm g, const Sched& S, const Epi& E) {
    const int tid = threadIdx.x, wid = __builtin_amdgcn_readfirstlane(tid >> 6), lane = tid & 63, wr = wid >> 2, wc = wid & 3, fr = lane & 15, fq = lane >> 4;
    const int K = g.K, nt = K / BK;
    unsigned voffA[2], voffB[2];
#pragma unroll
    for (int i = 0; i < 2; ++i) { int R, C; stage_rc(tid * 16 + i * 8192, R, C); const int Rb = Epi::PERM ? ((R & ~31) + perm32(R & 31)) : R;
        voffA[i] = (unsigned)(R * K + C) * 2u; voffB[i] = (unsigned)(Rb * K + C) * 2u; }
    const size_t kstep = (size_t)(BK * 2);
    const size_t hstep = (size_t)HALF * K * 2;
    const size_t tstep = 2 * hstep;
    const unsigned ldsw = (unsigned)wid * 1024u;
    const int aoff = lds_byte(wr * 64 + fr, fq * 8), boff = lds_byte(wc * 32 + fr, fq * 8);
#define PG8_SA(b, h) (((b) * 2 + (h)) * HTB)
#define PG8_SB(b, h) ((4 + (b) * 2 + (h)) * HTB)
#define PG8_STAGE(bufoff, gbase, voff) do { _Pragma("unroll") for (int _i = 0; _i < 2; ++_i) \
        __builtin_amdgcn_global_load_lds((const unsigned*)((const char*)(gbase) + (voff)[_i]), (PG8_LAS unsigned*)(lds + (bufoff) + ldsw + _i * 8192), 16, 0, 0); } while (0)
#define PG8_LDA(dst, b, h) do { _Pragma("unroll") for (int m = 0; m < 4; ++m) _Pragma("unroll") for (int k = 0; k < 2; ++k) dst[m][k] = *(const PG8_LAS bf16x8*)(lds + PG8_SA(b, h) + aoff + m * 2048 + k * 1024); } while (0)
#define PG8_LDB(dst, b, h) do { _Pragma("unroll") for (int n = 0; n < 2; ++n) _Pragma("unroll") for (int k = 0; k < 2; ++k) dst[n][k] = *(const PG8_LAS bf16x8*)(lds + PG8_SB(b, h) + boff + n * 2048 + k * 1024); } while (0)
#define PG8_MMA(ai, bj, At, Bt) do { __builtin_amdgcn_s_setprio(1); _Pragma("unroll") for (int m = 0; m < 4; ++m) _Pragma("unroll") for (int n = 0; n < 2; ++n) _Pragma("unroll") for (int k = 0; k < 2; ++k) \
        acc[ai][bj][m][n] = __builtin_amdgcn_mfma_f32_16x16x32_bf16(Bt[n][k], At[m][k], acc[ai][bj][m][n], 0, 0, 0); __builtin_amdgcn_s_setprio(0); } while (0)
#define PG8_WAIT_V(n) asm volatile("s_waitcnt vmcnt(" #n ")" ::: "memory")
#define PG8_WAIT_L(n) asm volatile("s_waitcnt lgkmcnt(" #n ")" ::: "memory")
#define PG8_BAR __builtin_amdgcn_s_barrier()
#define PG8_SCHED __builtin_amdgcn_sched_barrier(0)
    Unit cur, nxt; int ui = 0;
    if (!S.next(0, cur)) return;
    f32x4 acc[2][2][4][2];
#pragma unroll
    for (int a = 0; a < 2; ++a)
#pragma unroll
        for (int b = 0; b < 2; ++b)
#pragma unroll
            for (int m = 0; m < 4; ++m)
#pragma unroll
                for (int n = 0; n < 2; ++n) acc[a][b][m][n] = (f32x4){0.f, 0.f, 0.f, 0.f};
    bf16x8 At[4][2], B0[2][2], B1[2][2];
    const char* cA = (const char*)g.A + (size_t)cur.pm * tstep; const char* cB = (const char*)g.Bt + (size_t)cur.pn * tstep;
    S.a_ready(cur);
    if constexpr (SP2) {
        PG8_STAGE(PG8_SB(0, 0), cB, voffB); PG8_STAGE(PG8_SB(0, 1), cB + hstep, voffB); PG8_STAGE(PG8_SA(0, 0), cA, voffA); PG8_STAGE(PG8_SA(0, 1), cA + hstep, voffA);
        if (wr == 1) PG8_BAR;
        PG8_WAIT_V(2); PG8_BAR;
        PG8_STAGE(PG8_SB(1, 0), cB + kstep, voffB); PG8_STAGE(PG8_SA(1, 0), cA + kstep, voffA); PG8_STAGE(PG8_SB(1, 1), cB + hstep + kstep, voffB);
        PG8_WAIT_V(6); PG8_BAR;
    } else {
        PG8_STAGE(PG8_SB(0, 0), cB, voffB); PG8_STAGE(PG8_SA(0, 0), cA, voffA); PG8_STAGE(PG8_SB(0, 1), cB + hstep, voffB); PG8_STAGE(PG8_SA(0, 1), cA + hstep, voffA);
        if (wr == 1) PG8_BAR;
        PG8_WAIT_V(4); PG8_BAR;
        PG8_STAGE(PG8_SB(1, 0), cB + kstep, voffB); PG8_STAGE(PG8_SA(1, 0), cA + kstep, voffA); PG8_STAGE(PG8_SB(1, 1), cB + hstep + kstep, voffB);
        PG8_WAIT_V(6); PG8_BAR;
    }
    for (;;) {
        const bool has_next = S.next(ui + 1, nxt);
        const char* nA = has_next ? (const char*)g.A + (size_t)nxt.pm * tstep : cA; const char* nB = has_next ? (const char*)g.Bt + (size_t)nxt.pn * tstep : cB;
        for (int t = 0; t < nt; t += 2) {
            const bool last = (t == nt - 2);
            const char* a1 = cA + (size_t)(t + 1) * kstep;
            const char* a2 = last ? nA : cA + (size_t)(t + 2) * kstep; const char* b2 = last ? nB : cB + (size_t)(t + 2) * kstep;
            const char* a3 = a2 + kstep; const char* b3 = b2 + kstep;
            if (last && has_next) S.a_ready(nxt);
            if constexpr (SP2) {
            PG8_LDB(B0, 0, 0); PG8_LDB(B1, 0, 1); PG8_SCHED; PG8_LDA(At, 0, 0); PG8_STAGE(PG8_SA(1, 1), a1 + hstep, voffA);
            PG8_WAIT_V(8); PG8_WAIT_L(0); PG8_BAR; PG8_MMA(0, 0, At, B0); PG8_MMA(0, 1, At, B1); PG8_BAR; PG8_SCHED;
            PG8_LDA(At, 0, 1); PG8_STAGE(PG8_SB(0, 0), b2, voffB); PG8_STAGE(PG8_SB(0, 1), b2 + hstep, voffB); PG8_STAGE(PG8_SA(0, 0), a2, voffA);
            PG8_WAIT_V(8); PG8_WAIT_L(0); PG8_BAR; PG8_MMA(1, 0, At, B0); PG8_MMA(1, 1, At, B1); PG8_BAR; PG8_SCHED;
            PG8_LDB(B0, 1, 0); PG8_LDB(B1, 1, 1); PG8_SCHED; PG8_LDA(At, 1, 0); PG8_STAGE(PG8_SA(0, 1), a2 + hstep, voffA);
            PG8_WAIT_V(8); PG8_WAIT_L(0); PG8_BAR; PG8_MMA(0, 0, At, B0); PG8_MMA(0, 1, At, B1); PG8_BAR; PG8_SCHED;
            PG8_LDA(At, 1, 1); PG8_STAGE(PG8_SB(1, 0), b3, voffB); PG8_STAGE(PG8_SB(1, 1), b3 + hstep, voffB); PG8_STAGE(PG8_SA(1, 0), a3, voffA);
            PG8_WAIT_V(8); PG8_WAIT_L(0); PG8_BAR; PG8_MMA(1, 0, At, B0); PG8_MMA(1, 1, At, B1); PG8_BAR; PG8_SCHED;
            } else {
            PG8_LDB(B0, 0, 0); PG8_SCHED; PG8_LDA(At, 0, 0); PG8_STAGE(PG8_SA(1, 1), a1 + hstep, voffA);
            PG8_WAIT_L(8); PG8_BAR; PG8_WAIT_L(0); PG8_MMA(0, 0, At, B0); PG8_BAR; PG8_SCHED;
            PG8_LDB(B1, 0, 1); PG8_STAGE(PG8_SB(0, 0), b2, voffB);
            PG8_BAR; PG8_WAIT_L(0); PG8_MMA(0, 1, At, B1); PG8_BAR;
            PG8_LDA(At, 0, 1); PG8_STAGE(PG8_SA(0, 0), a2, voffA);
            PG8_BAR; PG8_WAIT_L(0); PG8_MMA(1, 0, At, B0); PG8_BAR; PG8_SCHED;
            PG8_STAGE(PG8_SB(0, 1), b2 + hstep, voffB);
            PG8_WAIT_V(6); PG8_BAR; PG8_MMA(1, 1, At, B1); PG8_BAR;
            PG8_LDB(B0, 1, 0); PG8_SCHED; PG8_LDA(At, 1, 0); PG8_STAGE(PG8_SA(0, 1), a2 + hstep, voffA);
            PG8_WAIT_L(8); PG8_BAR; PG8_WAIT_L(0); PG8_MMA(0, 0, At, B0); PG8_BAR; PG8_SCHED;
            PG8_LDB(B1, 1, 1); PG8_STAGE(PG8_SB(1, 0), b3, voffB);
            PG8_BAR; PG8_WAIT_L(0); PG8_MMA(0, 1, At, B1); PG8_BAR;
            PG8_LDA(At, 1, 1); PG8_STAGE(PG8_SA(1, 0), a3, voffA);
            PG8_BAR; PG8_WAIT_L(0); PG8_MMA(1, 0, At, B0); PG8_BAR; PG8_SCHED;
            PG8_STAGE(PG8_SB(1, 1), b3 + hstep, voffB);
            PG8_WAIT_V(6); PG8_BAR; PG8_MMA(1, 1, At, B1); PG8_BAR;
            }
        }
        if constexpr (ALIGN_EPI) { if (wr == 0) PG8_BAR; }
        if constexpr (!Epi::AFTER_DRAIN) { E(acc, cur, wr, wc, fr, fq); S.done(cur); }
        if (!has_next) break;
#pragma unroll
        for (int a = 0; a < 2; ++a)
#pragma unroll
            for (int b = 0; b < 2; ++b)
#pragma unroll
                for (int m = 0; m < 4; ++m)
#pragma unroll
                    for (int n = 0; n < 2; ++n) acc[a][b][m][n] = (f32x4){0.f, 0.f, 0.f, 0.f};
        cur = nxt; cA = nA; cB = nB; ++ui;
        if constexpr (ALIGN_EPI) { if (wr == 1) PG8_BAR; }
    }
    PG8_WAIT_V(0);
    if constexpr (!ALIGN_EPI) { if (wr == 0) PG8_BAR; }
    PG8_BAR;
    if constexpr (Epi::AFTER_DRAIN) { E.fused(acc, cur, wr, wc, fr, fq, lds, wid, lane); S.done(cur); }
#undef PG8_SA
#undef PG8_SB
#undef PG8_STAGE
#undef PG8_LDA
#undef PG8_LDB
#undef PG8_MMA
#undef PG8_WAIT_V
#undef PG8_WAIT_L
#undef PG8_BAR
#undef PG8_SCHED
}
}
#define LAS __attribute__((address_space(3)))
typedef unsigned short bf16;
typedef float f32x4 __attribute__((ext_vector_type(4)));
typedef float f32x16 __attribute__((ext_vector_type(16)));
typedef short bf16x8 __attribute__((ext_vector_type(8)));
typedef short s16x4 __attribute__((ext_vector_type(4)));
typedef unsigned u32x4 __attribute__((ext_vector_type(4)));
typedef unsigned u32x2 __attribute__((ext_vector_type(2)));
#define LDS_WAIT() asm volatile("s_waitcnt lgkmcnt(0)" ::: "memory")

constexpr int MP = 16384, MS = 512, MT = MP + MS, DM = 1024, NZ = 2304, FF = 4096, PD = 256, SEQ = 8192, PROJ_W = 2312;
constexpr int ZQK = 0, ZV = 512, ZO = 1024, ZQA = 1536, ZKA = 2048, ZVA = 2176;
constexpr float EPS = 1e-6f;
constexpr int NWAVES = 8, NTHR = 512;
constexpr int LDS_BYTES = 147456;
constexpr size_t MiB = 1u << 20;
constexpr size_t WS_WIN = 0, WS_WOUT = 5 * MiB, WS_WUP = 7 * MiB, WS_WDN = 15 * MiB, WS_WPG = 23 * MiB, WS_WPP = 25 * MiB;
constexpr size_t WS_ACTA = 26 * MiB;
constexpr size_t WS_PP = 59 * MiB;
constexpr size_t WS_H = 92 * MiB;
constexpr size_t WS_Z = 92 * MiB;
constexpr size_t WS_MIX = 92 * MiB;
constexpr size_t WS_QC = 167 * MiB;
constexpr size_t WS_CLOC = 184 * MiB;
constexpr size_t WS_CPREV = 200 * MiB;
constexpr size_t WS_PBF = 208 * MiB;
constexpr size_t WS_GATES = 217 * MiB;
constexpr size_t WS_STATS = 218 * MiB;
constexpr size_t WS_D1P = 224 * MiB, WS_D1S = 0;
constexpr size_t WS_CTL = 25 * MiB + 512 * 1024, CTL_BYTES = 81920;
constexpr size_t WS_ATTS = 219 * MiB;
constexpr size_t WS_X2 = WS_ACTA;
constexpr size_t WS_MIXS = 3 * MiB;
constexpr size_t WS_XBUF = 2 * MiB;
constexpr int MISC_OFF = 131072 + 320;
constexpr size_t WS_END = 256 * MiB;
constexpr size_t O_Y = 0, O_CP = 17301504, O_NP = 17367040, O_MP = 17367552, O_CONVP = 17367560, O_KP = 17370632, O_VP = 17403400,
                 O_CS = 17436168, O_NS = 21630472, O_MS = 21663240, O_CONVS = 21663752, O_KS = 21860360, O_VS = 23957512, O_END = 26054664;

__device__ __forceinline__ float bf2f(unsigned short v) { return __uint_as_float(((unsigned)v) << 16); }
__device__ __forceinline__ float bflo(unsigned w) { return __uint_as_float(w << 16); }
__device__ __forceinline__ float bfhi(unsigned w) { return __uint_as_float(w & 0xffff0000u); }
__device__ __forceinline__ unsigned pk2(float lo, float hi) { return pg8::cvt_pk_bf16(lo, hi); }
__device__ __forceinline__ float wave_sum(float v) {
#pragma unroll
    for (int o = 1; o < 64; o <<= 1) v += __shfl_xor(v, o);
    return v;
}
__device__ __forceinline__ float wave_max(float v) {
#pragma unroll
    for (int o = 1; o < 64; o <<= 1) v = fmaxf(v, __shfl_xor(v, o));
    return v;
}
__device__ __forceinline__ float wave_incl_sum(float v, int lane) {
#pragma unroll
    for (int o = 1; o < 64; o <<= 1) { const float n = __shfl_up(v, o); if (lane >= o) v += n; }
    return v;
}
__device__ __forceinline__ float wave_incl_max(float v, int lane) {
#pragma unroll
    for (int o = 1; o < 64; o <<= 1) { const float n = __shfl_up(v, o); if (lane >= o) v = fmaxf(v, n); }
    return v;
}
__device__ __forceinline__ float sigmoidf_(float x) { return 1.f / (1.f + __expf(-x)); }
__device__ __forceinline__ int crow(int r, int hi) { return (r & 3) + 8 * (r >> 2) + 4 * hi; }

struct Args { const float* in[25]; float* out; unsigned char* ws; int ph_lo, ph_hi, coop, pad; };

__device__ __forceinline__ void transpose_item(const float* W, int ldw, int col0, int k0, bf16* WT, int K, int row0, LAS float* scr, int lane) {
    float tv[32];
#pragma unroll
    for (int i = 0; i < 32; ++i) { const int kk = 2 * i + (lane >> 5); tv[i] = W[(size_t)(k0 + kk) * ldw + col0 + (lane & 31)]; }
#pragma unroll
    for (int i = 0; i < 32; ++i) { const int kk = 2 * i + (lane >> 5); scr[kk * 33 + (lane & 31)] = tv[i]; }
    LDS_WAIT(); asm volatile("" ::: "memory");
    const int c = lane & 7;
#pragma unroll
    for (int j = 0; j < 4; ++j) { const int n = (lane >> 3) + 8 * j; const LAS float* s = scr + (8 * c) * 33 + n;
        u32x4 o; o.x = pk2(s[0 * 33], s[1 * 33]); o.y = pk2(s[2 * 33], s[3 * 33]); o.z = pk2(s[4 * 33], s[5 * 33]); o.w = pk2(s[6 * 33], s[7 * 33]);
        *(u32x4*)(WT + (size_t)(row0 + n) * K + k0 + 8 * c) = o; }
    LDS_WAIT(); asm volatile("" ::: "memory");
}

constexpr int I_IN = 16 * 72, I_PP = 4 * 32, I_OUT = 16 * 32, I_UP = 16 * 128, I_DN = 64 * 32, I_PG = 16 * 32;
constexpr int IT_EARLY = I_IN + I_PP, IT_ALL = I_IN + I_PP + I_OUT + I_UP + I_DN + I_PG;
__device__ __forceinline__ void transpose_items(const Args& a, LAS unsigned char* lds, int lo, int hi, int gw, int NGW, int lane, int wave) {
    unsigned char* ws = a.ws;
    LAS float* scr = (LAS float*)(lds + wave * 16384);
    for (int it = lo + gw; it < hi; it += NGW) {
        int r = it;
        if (r < I_IN) { const int kb = r / 72, nb = r % 72; transpose_item(a.in[11], PROJ_W, 32 * nb + (nb >= 48 ? 8 : 0), 64 * kb, (bf16*)(ws + WS_WIN), 1024, 32 * nb, scr, lane); continue; } r -= I_IN;
        if (r < I_PP) { const int kb = r / 32, nb = r % 32; transpose_item(a.in[24], 1024, 32 * nb, 64 * kb, (bf16*)(ws + WS_WPP), 256, 32 * nb, scr, lane); continue; } r -= I_PP;
        if (r < I_OUT) { const int kb = r / 32, nb = r % 32; transpose_item(a.in[17], 1024, 32 * nb, 64 * kb, (bf16*)(ws + WS_WOUT), 1024, 32 * nb, scr, lane); continue; } r -= I_OUT;
        if (r < I_UP) { const int kb = r / 128, nb = r % 128; transpose_item(a.in[20], 4096, 32 * nb, 64 * kb, (bf16*)(ws + WS_WUP), 1024, 32 * nb, scr, lane); continue; } r -= I_UP;
        if (r < I_DN) { const int kb = r / 32, nb = r % 32; transpose_item(a.in[21], 1024, 32 * nb, 64 * kb, (bf16*)(ws + WS_WDN), 4096, 32 * nb, scr, lane); continue; } r -= I_DN;
        { const int kb = r / 32, nb = r % 32; transpose_item(a.in[23], 1024, 32 * nb, 64 * kb, (bf16*)(ws + WS_WPG), 1024, 32 * nb, scr, lane); }
    }
}
__device__ __forceinline__ void p0_prologue(const Args& a, LAS unsigned char* lds, int tid, int lane, int wave) {
    unsigned char* ws = a.ws;
    const int gw = blockIdx.x * NWAVES + wave, NGW = gridDim.x * NWAVES;
    transpose_items(a, lds, 0, IT_EARLY, gw, NGW, lane, wave);
    __syncthreads();
    LAS float* wg = (LAS float*)lds;
    for (int i = tid; i < 8192; i += NTHR) wg[i] = a.in[11][(size_t)(i >> 3) * PROJ_W + 1536 + (i & 7)];
    __syncthreads();
    const float* gpre = a.in[10];
    bf16* XN = (bf16*)(ws + WS_ACTA); bf16* PBF = (bf16*)(ws + WS_PBF); float* GATES = (float*)(ws + WS_GATES);
    f32x4 gq[4];
#pragma unroll
    for (int j = 0; j < 4; ++j) gq[j] = *(const f32x4*)(gpre + 4 * lane + 256 * j);
    f32x4 nv[4], npv;
    { const int m = gw < MT ? gw : 0; const float* xr = m < MP ? a.in[0] + (size_t)m * DM : a.in[1] + (size_t)(m - MP) * DM; const float* pr = m < MP ? a.in[2] + (size_t)m * PD : a.in[3] + (size_t)(m - MP) * PD;
#pragma unroll
      for (int j = 0; j < 4; ++j) nv[j] = *(const f32x4*)(xr + 4 * lane + 256 * j);
      npv = *(const f32x4*)(pr + 4 * lane); }
    for (int m = gw; m < MT; m += NGW) {
        f32x4 v[4]; float s = 0.f;
#pragma unroll
        for (int j = 0; j < 4; ++j) { v[j] = nv[j]; s += (v[j][0] * v[j][0] + v[j][1] * v[j][1]) + (v[j][2] * v[j][2] + v[j][3] * v[j][3]); }
        const f32x4 pv = npv;
        { const int m2 = (m + NGW < MT) ? m + NGW : m; const float* xr = m2 < MP ? a.in[0] + (size_t)m2 * DM : a.in[1] + (size_t)(m2 - MP) * DM; const float* pr = m2 < MP ? a.in[2] + (size_t)m2 * PD : a.in[3] + (size_t)(m2 - MP) * PD;
#pragma unroll
          for (int j = 0; j < 4; ++j) nv[j] = *(const f32x4*)(xr + 4 * lane + 256 * j);
          npv = *(const f32x4*)(pr + 4 * lane); }
        const float rs = 1.f / sqrtf(wave_sum(s) * (1.f / DM) + EPS);
        if (m < MP) {
#pragma unroll
            for (int j = 0; j < 4; ++j) { u32x2 o; o.x = pk2(v[j][0], v[j][1]); o.y = pk2(v[j][2], v[j][3]); *(u32x2*)((bf16*)(ws + WS_D1P) + (size_t)m * DM + 4 * lane + 256 * j) = o; } }
        float ga[8];
#pragma unroll
        for (int q = 0; q < 8; ++q) ga[q] = 0.f;
#pragma unroll
        for (int j = 0; j < 4; ++j) { const f32x4 g = gq[j];
#pragma unroll
            for (int e = 0; e < 4; ++e) { v[j][e] = v[j][e] * rs * g[e]; const LAS f32x4* wp = (const LAS f32x4*)(wg + (4 * lane + 256 * j + e) * 8); const f32x4 w0 = wp[0], w1 = wp[1];
                ga[0] += v[j][e] * w0[0]; ga[1] += v[j][e] * w0[1]; ga[2] += v[j][e] * w0[2]; ga[3] += v[j][e] * w0[3];
                ga[4] += v[j][e] * w1[0]; ga[5] += v[j][e] * w1[1]; ga[6] += v[j][e] * w1[2]; ga[7] += v[j][e] * w1[3]; }
            u32x2 o; o.x = pk2(v[j][0], v[j][1]); o.y = pk2(v[j][2], v[j][3]);
            *(u32x2*)(XN + (size_t)m * DM + 4 * lane + 256 * j) = o; }
        {
            const bool b0 = lane & 1, b1 = lane & 2, b2 = lane & 4;
            float k4[4], k2[2];
#pragma unroll
            for (int q = 0; q < 4; ++q) { const float send = b0 ? ga[q] : ga[q + 4]; const float recv = __shfl_xor(send, 1); k4[q] = (b0 ? ga[q + 4] : ga[q]) + recv; }
#pragma unroll
            for (int q = 0; q < 2; ++q) { const float send = b1 ? k4[q] : k4[q + 2]; const float recv = __shfl_xor(send, 2); k2[q] = (b1 ? k4[q + 2] : k4[q]) + recv; }
            const float send = b2 ? k2[0] : k2[1]; float t = (b2 ? k2[1] : k2[0]) + __shfl_xor(send, 4);
            t += __shfl_xor(t, 8); t += __shfl_xor(t, 16); t += __shfl_xor(t, 32);
            if (lane < 8) GATES[(size_t)m * 8 + 4 * (lane & 1) + (lane & 2) + ((lane >> 2) & 1)] = t; }
        { u32x2 o; o.x = pk2(pv[0], pv[1]); o.y = pk2(pv[2], pv[3]); *(u32x2*)(PBF + (size_t)m * PD + 4 * lane) = o; }
    }
}

__device__ __forceinline__ void chunk_scalars(const float* GATES, const float* bg, int row0, int h, LAS float* SA, LAS float* SB, LAS float* TMP, int tid, int lane, int wave, float& a_out, float& b_out) {
    float s = 0.f, gi = 0.f;
    if (tid < 128) { const float* gp = GATES + (size_t)(row0 + tid) * 8; gi = gp[h] + bg[h]; const float gf = gp[4 + h] + bg[4 + h];
        const float lf = fminf(gf, 0.f) - log1pf(expf(-fabsf(gf))); s = wave_incl_sum(lf, lane); if (lane == 63) TMP[wave] = s; }
    __syncthreads();
    if (tid < 128) { if (wave == 1) s += TMP[0]; SB[tid] = s; SA[tid] = gi - s; }
    a_out = gi - s; b_out = s;
    __syncthreads();
}
template <int NT>
__device__ __forceinline__ void load_vt(const bf16* Z, int row0, int colbase, LAS unsigned* VT32, int t) {
#pragma unroll
    for (int i = 0; i < 1024 / NT; ++i) { const int item = t + NT * i, ch = item & 15, tp = item >> 4;
        const bf16* p0 = Z + (size_t)(row0 + 2 * tp) * NZ + colbase + ch * 8;
        const u32x4 a0 = *(const u32x4*)p0, b0 = *(const u32x4*)(p0 + NZ);
        LAS unsigned* d = VT32 + (ch * 8) * 68 + (((tp >> 2) ^ ch) * 4 + (tp & 3));
#pragma unroll
        for (int e = 0; e < 4; ++e) { d[(2 * e) * 68] = (a0[e] & 0xffffu) | (b0[e] << 16); d[(2 * e + 1) * 68] = (a0[e] >> 16) | (b0[e] & 0xffff0000u); } }
}
__device__ __forceinline__ int vt_off(int row, int oct) { return row * 136 + ((oct ^ ((row >> 3) & 15)) << 3); }

__device__ __forceinline__ void mlstm_b1_unit(const Args& a, LAS unsigned char* lds, int unit, int tid, int lane, int wave) {
    unsigned char* ws = a.ws;
    const bf16* Z = (const bf16*)(ws + WS_Z); bf16* QC = (bf16*)(ws + WS_QC); const float* GATES = (const float*)(ws + WS_GATES);
    float* CLOC = (float*)(ws + WS_CLOC); float* STATS = (float*)(ws + WS_STATS);
    const int bh = unit >> 6, c = unit & 63, b = bh >> 2, h = bh & 3, row0 = b * SEQ + c * 128;
    LAS unsigned* VT32 = (LAS unsigned*)lds; LAS unsigned* KT32 = (LAS unsigned*)(lds + 34816);
    LAS float* SA = (LAS float*)(lds + 52224); LAS float* SB = SA + 128; LAS float* SW = SA + 256; LAS float* TMP = SA + 384;
    float av, bv;
    chunk_scalars(GATES, a.in[12], row0, h, SA, SB, TMP, tid, lane, wave, av, bv);
    if (tid < 128) { const float wm = wave_max(av); if (lane == 0) TMP[4 + wave] = wm; }
    __syncthreads();
    const float amax = fmaxf(TMP[4], TMP[5]), blast = SB[127];
    if (tid < 128) SW[tid] = expf(av - amax);
    if (tid == 0) { STATS[65536 + unit] = blast + amax; STATS[65536 + 512 + unit] = blast; }
    __syncthreads();
    load_vt<NTHR>(Z, row0, ZV + h * 128, VT32, tid);
    {
        const float* cw = a.in[13];
#pragma unroll
        for (int it = 0; it < 2; ++it) {
            const int item = tid + NTHR * it, ch = item & 15, tp = item >> 4; const bool isk = ch >= 8;
            const int cc = (isk ? 256 : 0) + h * 64 + (ch & 7) * 8;
            const int t0 = 2 * tp; const float w0s = SW[t0], w1s = SW[t0 + 1];
            float r[5][8];
#pragma unroll
            for (int j = 0; j < 5; ++j) { const int tt = c * 128 + t0 - 3 + j;
                if (tt >= 0) { const u32x4 w = *(const u32x4*)(Z + (size_t)(row0 + t0 - 3 + j) * NZ + cc);
#pragma unroll
                    for (int e = 0; e < 4; ++e) { r[j][2 * e] = bflo(w[e]); r[j][2 * e + 1] = bfhi(w[e]); } }
                else {
#pragma unroll
                    for (int e = 0; e < 8; ++e) r[j][e] = 0.f; } }
            float o0[8], o1[8];
#pragma unroll
            for (int e = 0; e < 8; ++e) { const float c0 = cw[cc + e], c1 = cw[512 + cc + e], c2 = cw[1024 + cc + e], c3 = cw[1536 + cc + e];
                float x0 = c0 * r[0][e] + c1 * r[1][e] + c2 * r[2][e] + c3 * r[3][e]; float x1 = c0 * r[1][e] + c1 * r[2][e] + c2 * r[3][e] + c3 * r[4][e];
                x0 = x0 * sigmoidf_(x0); x1 = x1 * sigmoidf_(x1);
                if (!isk) { x0 *= 0.125f; x1 *= 0.125f; }
                o0[e] = x0; o1[e] = x1; }
            u32x4 s0, s1;
#pragma unroll
            for (int e = 0; e < 4; ++e) { s0[e] = pk2(o0[2 * e], o0[2 * e + 1]); s1[e] = pk2(o1[2 * e], o1[2 * e + 1]); }
            *(u32x4*)(QC + (size_t)(row0 + t0) * 512 + cc) = s0; *(u32x4*)(QC + (size_t)(row0 + t0 + 1) * 512 + cc) = s1;
            if (isk) { const int g = ch & 7; LAS unsigned* d = KT32 + (g * 8) * 68 + (((tp >> 2) ^ g) * 4 + (tp & 3));
#pragma unroll
                for (int e = 0; e < 8; ++e) d[e * 68] = pk2(o0[e] * w0s, o1[e] * w1s); }
        }
    }
    __syncthreads();
    {
        const int vt = wave >> 1, dt = wave & 1, l32 = lane & 31, hi = lane >> 5;
        const LAS bf16* VT = (const LAS bf16*)VT32; const LAS bf16* KT = (const LAS bf16*)KT32;
        f32x16 acc = {};
#pragma unroll
        for (int s0 = 0; s0 < 128; s0 += 16) {
            const int oct = (s0 >> 3) + hi, rv = vt * 32 + l32, rk = dt * 32 + l32;
            const bf16x8 A = *(const LAS bf16x8*)(VT + vt_off(rv, oct));
            const bf16x8 B = *(const LAS bf16x8*)(KT + rk * 136 + ((oct ^ ((rk >> 3) & 7)) << 3));
            acc = __builtin_amdgcn_mfma_f32_32x32x16_bf16(A, B, acc, 0, 0, 0); }
        float* cp = CLOC + (size_t)unit * 8192 + dt * 32 + l32;
#pragma unroll
        for (int r = 0; r < 16; ++r) cp[(vt * 32 + crow(r, hi)) * 64] = acc[r];
        if (tid < 64) { float s = 0.f;
#pragma unroll
            for (int q = 0; q < 16; ++q) { const u32x4 w = *(const LAS u32x4*)(KT + tid * 136 + 8 * q);
#pragma unroll
                for (int e = 0; e < 4; ++e) s += bflo(w[e]) + bfhi(w[e]); }
            STATS[unit * 64 + tid] = s; }
    }
    __syncthreads();
}

__device__ __forceinline__ void mlstm_scan(const Args& a, int tid) {
    unsigned char* ws = a.ws;
    const float* CLOC = (const float*)(ws + WS_CLOC); bf16* CPREV = (bf16*)(ws + WS_CPREV); float* STATS = (float*)(ws + WS_STATS);
    const float* NLOC = STATS; float* NPREV = STATS + 32768; const float* MLOC = STATS + 65536; const float* BLAST = STATS + 65536 + 512; float* MPREV = STATS + 65536 + 1024;
    const int j = blockIdx.x;
    if (j < 128) {
        const int e = j * 512 + tid, bh = e >> 13, idx = e & 8191;
        float C = 0.f, m = 0.f;
        {
            constexpr int c0 = 0;
            float cl[64];
#pragma unroll
            for (int i = 0; i < 64; ++i) cl[i] = CLOC[(size_t)(bh * 64 + i) * 8192 + idx];
#pragma unroll
            for (int i = 0; i < 64; ++i) { const int u = bh * 64 + c0 + i; const float bl = BLAST[u], ml = MLOC[u];
                CPREV[(size_t)u * 8192 + idx] = (bf16)(pk2(C, 0.f) & 0xffffu);
                const float mn = fmaxf(bl + m, ml); C = expf(bl + m - mn) * C + expf(ml - mn) * cl[i]; m = mn; }
        }
        const int v = idx >> 6, d = idx & 63;
        a.out[O_CP + (size_t)bh * 8192 + d * 128 + v] = C;
    } else if (j == 128) {
        const int bh = tid >> 6, d = tid & 63;
        float n = 0.f, m = 0.f;
        for (int c = 0; c < 64; ++c) { const int u = bh * 64 + c; const float bl = BLAST[u], ml = MLOC[u];
            NPREV[u * 64 + d] = n; if (d == 0) MPREV[u] = m;
            const float mn = fmaxf(bl + m, ml); n = expf(bl + m - mn) * n + expf(ml - mn) * NLOC[u * 64 + d]; m = mn; }
        a.out[O_NP + bh * 64 + d] = n; if (d == 0) a.out[O_MP + bh] = m;
    }
}

__device__ __forceinline__ void mlstm_b3_pair(const Args& a, LAS unsigned char* lds0, int u0, int tid, int lane, int wave) {
    unsigned char* ws = a.ws;
    const bf16* Z = (const bf16*)(ws + WS_Z); const bf16* QC = (const bf16*)(ws + WS_QC); const float* GATES = (const float*)(ws + WS_GATES);
    const bf16* CPREV = (const bf16*)(ws + WS_CPREV); const float* STATS = (const float*)(ws + WS_STATS); bf16* YMIX = (bf16*)(ws + WS_ACTA);
    const int half = wave >> 2, lw = wave & 3, lt = tid & 255, unit = u0 + half;
    LAS unsigned char* lds = lds0 + half * 57344;
    const int bh = unit >> 6, c = unit & 63, b = bh >> 2, h = bh & 3, row0 = b * SEQ + c * 128;
    LAS unsigned* VT32 = (LAS unsigned*)lds; LAS bf16* KL = (LAS bf16*)(lds + 34816);
    LAS float* SA = (LAS float*)(lds + 53248); LAS float* SB = SA + 128; LAS float* SM = SA + 256; LAS float* TMP = SA + 384; LAS float* NP = SA + 400; LAS float* GM = SA + 464;
    const int tb = lw, l32 = lane & 31, hi = lane >> 5, t = tb * 32 + l32;
    const size_t rowt = (size_t)(row0 + t);
    bf16x8 qf[4];
#pragma unroll
    for (int d0 = 0; d0 < 4; ++d0) qf[d0] = *(const bf16x8*)(QC + rowt * 512 + h * 64 + d0 * 16 + 8 * hi);
    bf16x8 cf[4][4];
#pragma unroll
    for (int vt = 0; vt < 4; ++vt)
#pragma unroll
        for (int d0 = 0; d0 < 4; ++d0) cf[vt][d0] = *(const bf16x8*)(CPREV + ((size_t)unit * 128 + vt * 32 + l32) * 64 + d0 * 16 + 8 * hi);
    {
#pragma unroll
      for (int i = 0; i < 4; ++i) { const int idx = lt + 256 * i, s = idx >> 3, ch = idx & 7;
          *(LAS u32x4*)(KL + s * 72 + ch * 8) = *(const u32x4*)(QC + (size_t)(row0 + s) * 512 + 256 + h * 64 + ch * 8); } }
    const float mprev = STATS[65536 + 1024 + unit];
    float s = 0.f, gi = 0.f, pm = 0.f;
    if (lt < 128) { const float* gp = GATES + (size_t)(row0 + lt) * 8; gi = gp[h] + a.in[12][h]; const float gf = gp[4 + h] + a.in[12][4 + h];
        const float lf = fminf(gf, 0.f) - log1pf(expf(-fabsf(gf))); s = wave_incl_sum(lf, lane); if (lane == 63) TMP[lw] = s; }
    if (lt >= 128 && lt < 192) NP[lt - 128] = STATS[32768 + unit * 64 + (lt - 128)];
    if (lt >= 192) { GM[lt - 192] = a.in[14][h * 128 + lt - 192]; GM[lt - 128] = a.in[14][h * 128 + lt - 128]; }
    load_vt<256>(Z, row0, ZV + h * 128, VT32, lt);
    __syncthreads();
    float av = 0.f;
    if (lt < 128) { if (lw == 1) s += TMP[0]; SB[lt] = s; av = gi - s; SA[lt] = av; pm = wave_incl_max(av, lane); if (lane == 63) TMP[4 + lw] = pm; }
    __syncthreads();
    if (lt < 128) { if (lw == 1) pm = fmaxf(pm, TMP[4]); SM[lt] = fmaxf(mprev, pm); }
    __syncthreads();
    const float L2E = 1.4426950408889634f;
    const float Mt = SM[t], winter = __builtin_amdgcn_exp2f((mprev - Mt) * L2E);
    f32x16 acc[4];
#pragma unroll
    for (int vt = 0; vt < 4; ++vt) { acc[vt] = (f32x16){};
#pragma unroll
        for (int d0 = 0; d0 < 4; ++d0) acc[vt] = __builtin_amdgcn_mfma_f32_32x32x16_bf16(cf[vt][d0], qf[d0], acc[vt], 0, 0, 0);
#pragma unroll
        for (int r = 0; r < 16; ++r) acc[vt][r] *= winter; }
    float den = 0.f;
    const LAS bf16* VT = (const LAS bf16*)VT32;
    for (int st = 0; st <= tb; ++st) {
        f32x16 S = {};
#pragma unroll
        for (int d0 = 0; d0 < 4; ++d0) { const bf16x8 A = *(const LAS bf16x8*)(KL + (st * 32 + l32) * 72 + d0 * 16 + 8 * hi);
            S = __builtin_amdgcn_mfma_f32_32x32x16_bf16(A, qf[d0], S, 0, 0, 0); }
        float p[16];
#pragma unroll
        for (int r = 0; r < 16; ++r) { const int sl = crow(r, hi); const float w = __builtin_amdgcn_exp2f((SA[st * 32 + sl] - Mt) * L2E); float pv = S[r] * w; if (st == tb && sl > l32) pv = 0.f; p[r] = pv; den += pv; }
        u32x4 pb0, pb1;
#pragma unroll
        for (int e = 0; e < 4; ++e) { pb0[e] = pk2(p[2 * e], p[2 * e + 1]); pb1[e] = pk2(p[8 + 2 * e], p[8 + 2 * e + 1]); }
#pragma unroll
        for (int vt = 0; vt < 4; ++vt) { const int rv = vt * 32 + l32;
            const u32x2 x0 = *(const LAS u32x2*)(VT + vt_off(rv, st * 4 + 0) + 4 * hi), x1 = *(const LAS u32x2*)(VT + vt_off(rv, st * 4 + 1) + 4 * hi), x2 = *(const LAS u32x2*)(VT + vt_off(rv, st * 4 + 2) + 4 * hi), x3 = *(const LAS u32x2*)(VT + vt_off(rv, st * 4 + 3) + 4 * hi);
            const u32x4 A0 = {x0.x, x0.y, x1.x, x1.y}, A1 = {x2.x, x2.y, x3.x, x3.y};
            acc[vt] = __builtin_amdgcn_mfma_f32_32x32x16_bf16(__builtin_bit_cast(bf16x8, A0), __builtin_bit_cast(bf16x8, pb0), acc[vt], 0, 0, 0);
            acc[vt] = __builtin_amdgcn_mfma_f32_32x32x16_bf16(__builtin_bit_cast(bf16x8, A1), __builtin_bit_cast(bf16x8, pb1), acc[vt], 0, 0, 0); }
    }
    den += __shfl_xor(den, 32);
    float qn = 0.f;
#pragma unroll
    for (int d0 = 0; d0 < 4; ++d0)
#pragma unroll
        for (int e = 0; e < 8; ++e) qn += bf2f((unsigned short)qf[d0][e]) * NP[d0 * 16 + 8 * hi + e];
    qn += __shfl_xor(qn, 32);
    den += winter * qn;
    const float mt = SB[t] + Mt;
    const float inv = 1.f / fmaxf(fabsf(den), __builtin_amdgcn_exp2f(-mt * L2E));
    float ss = 0.f;
#pragma unroll
    for (int vt = 0; vt < 4; ++vt)
#pragma unroll
        for (int r = 0; r < 16; ++r) { acc[vt][r] *= inv; ss += acc[vt][r] * acc[vt][r]; }
    ss += __shfl_xor(ss, 32);
    const float rn = 1.f / sqrtf(ss * (1.f / 128.f) + EPS);
    u32x4 ogr[8];
#pragma unroll
    for (int i = 0; i < 8; ++i) { const int rr = 4 * i + (lane >> 4), ch = lane & 15; ogr[i] = *(const u32x4*)(Z + (size_t)(row0 + tb * 32 + rr) * NZ + ZO + h * 128 + ch * 8); }
    __syncthreads();
    LAS bf16* STG = (LAS bf16*)lds + lw * 4352;
#pragma unroll
    for (int vt = 0; vt < 4; ++vt) {
        f32x4 g4[4];
#pragma unroll
        for (int rg = 0; rg < 4; ++rg) g4[rg] = *(const LAS f32x4*)(GM + vt * 32 + 8 * rg + 4 * hi);
#pragma unroll
        for (int rg = 0; rg < 4; ++rg) { const int v = vt * 32 + 8 * rg + 4 * hi;
            u32x2 o; o.x = pk2(acc[vt][4 * rg] * rn * g4[rg][0], acc[vt][4 * rg + 1] * rn * g4[rg][1]); o.y = pk2(acc[vt][4 * rg + 2] * rn * g4[rg][2], acc[vt][4 * rg + 3] * rn * g4[rg][3]);
            *(LAS u32x2*)(STG + l32 * 136 + v) = o; } }
    LDS_WAIT(); asm volatile("" ::: "memory");
#pragma unroll
    for (int i = 0; i < 8; ++i) { const int rr = 4 * i + (lane >> 4), ch = lane & 15; const u32x4 hw = *(const LAS u32x4*)(STG + rr * 136 + ch * 8); const u32x4 ow = ogr[i];
        u32x4 y;
#pragma unroll
        for (int e = 0; e < 4; ++e) y[e] = pk2(sigmoidf_(bflo(ow[e])) * bflo(hw[e]), sigmoidf_(bfhi(ow[e])) * bfhi(hw[e]));
        *(u32x4*)(YMIX + (size_t)(row0 + tb * 32 + rr) * DM + h * 128 + ch * 8) = y; }
    __syncthreads();
}
#define XB_TMO      128
#define XB_XCNT(j)  (256  + 64 * (j))
#define XB_XSUB(j)  (1280 + 64 * (j))
#define XB_XGEN(j)  (2304 + 64 * (j))
#define XB_TOP      3328
#define XB_TOPGEN   3392
#define XCD_BAR_WORDS 3456
#define XB_SPIN_CAP (1u << 18)

__device__ __forceinline__ unsigned xb_ld(unsigned* p)              { return __hip_atomic_load(p, __ATOMIC_RELAXED, __HIP_MEMORY_SCOPE_AGENT); }
__device__ __forceinline__ unsigned xb_add(unsigned* p, unsigned v) { return __hip_atomic_fetch_add(p, v, __ATOMIC_RELAXED, __HIP_MEMORY_SCOPE_AGENT); }
__device__ __forceinline__ unsigned xb_xcc_id() { return (unsigned)__builtin_amdgcn_s_getreg((3 << 11) | 20) & 0xFu; }
#define XB_SPIN(cond, bar) do { unsigned _sp = 0; while (cond) { __builtin_amdgcn_s_sleep(1); \
    if ((++_sp & 255u) == 0u) { if (xb_ld(&(bar)[XB_TMO])) break; if (_sp > XB_SPIN_CAP) { atomicAdd(&(bar)[XB_TMO], 1u); break; } } } } while (0)

struct XcdBarrier {
    unsigned* bar; unsigned x;
    volatile LAS unsigned* st;
};

__device__ __forceinline__ XcdBarrier xcd_barrier_post(unsigned* bar, volatile LAS unsigned* st) {
    XcdBarrier b; b.bar = bar; b.x = xb_xcc_id(); b.st = st;
    if (threadIdx.x == 0) (void)xb_add(&bar[XB_XCNT(b.x)], 1u);
    return b;
}
__device__ __forceinline__ void xcd_barrier_complete(unsigned* bar, unsigned x, unsigned& nloc, unsigned& nx) {
    const unsigned G = gridDim.x * gridDim.y * gridDim.z;
    unsigned sum, cnt, mine, sp = 0u;
    for (;;) {
        sum = 0u; cnt = 0u; mine = 0u;
#pragma unroll
        for (unsigned j = 0; j < 16; ++j) { const unsigned c = xb_ld(&bar[XB_XCNT(j)]); sum += c; cnt += (c > 0u) ? 1u : 0u; mine = (j == x) ? c : mine; }
        if (sum == G) break;
        __builtin_amdgcn_s_sleep(1);
        if ((++sp & 255u) == 0u) { if (xb_ld(&bar[XB_TMO])) break; if (sp > XB_SPIN_CAP) { atomicAdd(&bar[XB_TMO], 1u); break; } }
    }
    nloc = mine > 0u ? mine : 1u; nx = cnt > 0u ? cnt : 1u;
}

__device__ __forceinline__ void xcd_barrier(const XcdBarrier& b) {
    asm volatile("s_waitcnt vmcnt(0)" ::: "memory");
    __syncthreads();
    if (threadIdx.x == 0) {
        unsigned* bar = b.bar;
        __builtin_amdgcn_s_waitcnt(0);
        unsigned nloc = b.st[0], nx = b.st[1];
        if (nloc == 0u) { xcd_barrier_complete(bar, b.x, nloc, nx); b.st[0] = nloc; b.st[1] = nx; }
        const unsigned old = xb_add(&bar[XB_XSUB(b.x)], 1u);
        const unsigned gen = old / nloc;
        if (old + 1u == (gen + 1u) * nloc) {
            __builtin_amdgcn_fence(__ATOMIC_RELEASE, "agent");
            asm volatile("s_waitcnt vmcnt(0)" ::: "memory");
            const unsigned og = xb_add(&bar[XB_TOP], 1u);
            const unsigned tg = og / nx;
            if (og + 1u == (tg + 1u) * nx) xb_add(&bar[XB_TOPGEN], 1u);
            else XB_SPIN(xb_ld(&bar[XB_TOPGEN]) == tg, bar);
            __builtin_amdgcn_fence(__ATOMIC_ACQUIRE, "agent");
            xb_add(&bar[XB_XGEN(b.x)], 1u);
            asm volatile("s_waitcnt vmcnt(0)" ::: "memory");
        } else {
            XB_SPIN(xb_ld(&bar[XB_XGEN(b.x)]) == gen, bar);
            __builtin_amdgcn_fence(__ATOMIC_ACQUIRE, "agent");
            asm volatile("s_waitcnt vmcnt(0)" ::: "memory");
        }
    }
    __syncthreads();
}
__device__ __forceinline__ void swa_prompt_unit(const Args& a, LAS unsigned char* lds, int unit, int tid, int lane, int wave) {
    unsigned char* ws = a.ws;
    const bf16* Z = (const bf16*)(ws + WS_Z); bf16* YMIX = (bf16*)(ws + WS_ACTA);
    const int q4 = unit & 3, n = (unit >> 2) & 63, b = unit >> 8;
    LAS bf16* KL = (LAS bf16*)lds; LAS unsigned* VT32 = (LAS unsigned*)(lds + 46080); LAS float* SSP = (LAS float*)(lds + 89088);
    const int tok0 = n * 128 - 128 + q4 * 32;
    bf16x8 qf[4];
    { const int hq_ = wave, l32_ = lane & 31, hi_ = lane >> 5; const size_t row_ = (size_t)(b * SEQ + n * 128 + q4 * 32 + l32_);
#pragma unroll
      for (int d0 = 0; d0 < 4; ++d0) qf[d0] = *(const bf16x8*)(Z + row_ * NZ + ZQA + hq_ * 64 + d0 * 16 + 8 * hi_); }
#pragma unroll
    for (int i = 0; i < 5; ++i) { const int idx = tid + NTHR * i, ch = idx & 7, rk = idx >> 3, kv = rk / 160, lk = rk % 160, tok = tok0 + lk;
        u32x4 w = {0u, 0u, 0u, 0u}; if (tok >= 0) w = *(const u32x4*)(Z + (size_t)(b * SEQ + tok) * NZ + ZKA + kv * 64 + ch * 8);
        *(LAS u32x4*)(KL + (kv * 160 + lk) * 72 + ch * 8) = w; }
#pragma unroll
    for (int i = 0; i < 3; ++i) { const int idx = tid + NTHR * i;
        if (idx < 1280) { const int ch = idx & 7, rest = idx >> 3, kv = rest / 80, kp = rest % 80, tok = tok0 + 2 * kp;
            u32x4 a0 = {0u, 0u, 0u, 0u}, b0 = {0u, 0u, 0u, 0u};
            if (tok >= 0) { const bf16* p = Z + (size_t)(b * SEQ + tok) * NZ + ZVA + kv * 64 + ch * 8; a0 = *(const u32x4*)p; b0 = *(const u32x4*)(p + NZ); }
            LAS unsigned* d = VT32 + (kv * 64 + ch * 8) * 84 + kp;
#pragma unroll
            for (int e = 0; e < 4; ++e) { d[(2 * e) * 84] = (a0[e] & 0xffffu) | (b0[e] << 16); d[(2 * e + 1) * 84] = (a0[e] >> 16) | (b0[e] & 0xffff0000u); } } }
    __syncthreads();
    const int hq = wave, kv = hq >> 2, l32 = lane & 31, hi = lane >> 5;
    const float slope = exp2f(-(float)(hq + 1)), L2E = 1.4426950408889634f, sink2 = a.in[15][hq] * L2E;
    const LAS bf16* VT = (const LAS bf16*)VT32;
    const size_t row = (size_t)(b * SEQ + n * 128 + q4 * 32 + l32);
    f32x16 O[2];
    {
        float mrun = sink2, ls = 0.f;
        O[0] = (f32x16){}; O[1] = (f32x16){};
#pragma unroll 1
        for (int j = 0; j < 5; ++j) {
            f32x16 S = {};
#pragma unroll
            for (int d0 = 0; d0 < 4; ++d0) { const bf16x8 A = *(const LAS bf16x8*)(KL + (kv * 160 + 32 * j + l32) * 72 + d0 * 16 + 8 * hi);
                S = __builtin_amdgcn_mfma_f32_32x32x16_bf16(A, qf[d0], S, 0, 0, 0); }
            float mx = mrun;
#pragma unroll
            for (int r = 0; r < 16; ++r) { const int lk = 32 * j + crow(r, hi); const int dist = 128 + l32 - lk;
                const bool valid = dist >= 0 && dist <= 128 && (n > 0 || q4 * 32 + lk >= 128);
                const float sc = valid ? (S[r] * 0.125f - slope * (float)dist) * L2E : -INFINITY; S[r] = sc; mx = fmaxf(mx, sc); }
            mx = fmaxf(mx, __shfl_xor(mx, 32));
            const float alpha = __builtin_amdgcn_exp2f(mrun - mx); mrun = mx;
            float lt = 0.f;
#pragma unroll
            for (int r = 0; r < 16; ++r) { const float e = __builtin_amdgcn_exp2f(S[r] - mx); S[r] = e; lt += e; }
            ls = ls * alpha + lt;
            u32x4 pb0, pb1;
#pragma unroll
            for (int e = 0; e < 4; ++e) { pb0[e] = pk2(S[2 * e], S[2 * e + 1]); pb1[e] = pk2(S[8 + 2 * e], S[8 + 2 * e + 1]); }
#pragma unroll
            for (int dt = 0; dt < 2; ++dt) { const LAS bf16* vp = VT + (kv * 64 + dt * 32 + l32) * 168 + 32 * j + 4 * hi;
                const u32x2 x0 = *(const LAS u32x2*)vp, x1 = *(const LAS u32x2*)(vp + 8), x2 = *(const LAS u32x2*)(vp + 16), x3 = *(const LAS u32x2*)(vp + 24);
                const u32x4 A0 = {x0.x, x0.y, x1.x, x1.y}, A1 = {x2.x, x2.y, x3.x, x3.y};
#pragma unroll
                for (int r = 0; r < 16; ++r) O[dt][r] *= alpha;
                O[dt] = __builtin_amdgcn_mfma_f32_32x32x16_bf16(__builtin_bit_cast(bf16x8, A0), __builtin_bit_cast(bf16x8, pb0), O[dt], 0, 0, 0);
                O[dt] = __builtin_amdgcn_mfma_f32_32x32x16_bf16(__builtin_bit_cast(bf16x8, A1), __builtin_bit_cast(bf16x8, pb1), O[dt], 0, 0, 0); } }
        ls += __shfl_xor(ls, 32); ls += __builtin_amdgcn_exp2f(sink2 - mrun);
        const float il = 1.f / ls; float ss = 0.f;
#pragma unroll
        for (int dt = 0; dt < 2; ++dt)
#pragma unroll
            for (int r = 0; r < 16; ++r) { O[dt][r] *= il; ss += O[dt][r] * O[dt][r]; }
        ss += __shfl_xor(ss, 32);
        if (hi == 0) SSP[hq * 32 + l32] = ss;
    }
    __syncthreads();
    const float* ga = a.in[16];
    {
        float tot = 0.f;
#pragma unroll
        for (int q = 0; q < 8; ++q) tot += SSP[q * 32 + l32];
        const float rn = 1.f / sqrtf(tot * (1.f / 512.f) + EPS);
#pragma unroll
        for (int dt = 0; dt < 2; ++dt)
#pragma unroll
            for (int rg = 0; rg < 4; ++rg) { const int col = hq * 64 + dt * 32 + 8 * rg + 4 * hi; const f32x4 g4 = *(const f32x4*)(ga + col);
                u32x2 o; o.x = pk2(O[dt][4 * rg] * rn * g4[0], O[dt][4 * rg + 1] * rn * g4[1]); o.y = pk2(O[dt][4 * rg + 2] * rn * g4[2], O[dt][4 * rg + 3] * rn * g4[3]);
                *(u32x2*)(YMIX + row * DM + 512 + col) = o; }
    }
    __syncthreads();
}

__device__ __forceinline__ void mlstm_sample_prefetch(const Args& a, int unit, int tid, float (&cs)[16]) {
    const int dg = tid >> 7, v = tid & 127; const float* C0 = a.in[4] + (size_t)unit * 8192;
#pragma unroll
    for (int dd = 0; dd < 16; ++dd) cs[dd] = C0[(dg * 16 + dd) * 128 + v];
}
__device__ __forceinline__ void mlstm_sample_unit(const Args& a, LAS unsigned char* lds, int unit, int tid, int lane, int wave, const float (&cs)[16]) {
    unsigned char* ws = a.ws;
    const bf16* Z = (const bf16*)(ws + WS_Z); const float* GATES = (const float*)(ws + WS_GATES); bf16* YMIX = (bf16*)(ws + WS_ACTA);
    const int b = unit >> 2, h = unit & 3; const int rowb = MP + b * 4;
    LAS float* QS = (LAS float*)lds; LAS float* KS = QS + 256; LAS float* VS = QS + 512; LAS float* SR = QS + 1024; LAS float* QN = QS + 1040; LAS float* RED = QS + 1048; LAS float* PART = QS + 1056;
    const float* bg = a.in[12];
    const float m0 = a.in[6][unit];
    float ig[4], bc[4], av[4], Mt[4]; float run = 0.f, pm = -INFINITY;
#pragma unroll
    for (int t = 0; t < 4; ++t) { const float* gp = GATES + (size_t)(rowb + t) * 8; ig[t] = gp[h] + bg[h]; const float gf = gp[4 + h] + bg[4 + h];
        run += fminf(gf, 0.f) - log1pf(expf(-fabsf(gf))); bc[t] = run; av[t] = ig[t] - run; pm = fmaxf(pm, av[t]); Mt[t] = fmaxf(m0, pm); }
    const float blast = bc[3], mnew = fmaxf(blast + m0, blast + pm), decay = expf(blast + m0 - mnew);
    float wk[4];
#pragma unroll
    for (int s = 0; s < 4; ++s) wk[s] = expf(blast + av[s] - mnew);
    {
        const int t = tid >> 7, cl = tid & 127; const int col = cl < 64 ? h * 64 + cl : 256 + h * 64 + (cl - 64);
        const float* cb = a.in[7] + (size_t)b * 3 * 512; const float* cw = a.in[13];
        float x = 0.f, raw = 0.f;
#pragma unroll
        for (int j = 0; j < 4; ++j) { const int i = t + j; const float u = i < 3 ? cb[i * 512 + col] : bf2f(Z[(size_t)(rowb + i - 3) * NZ + ZQK + col]); x += cw[j * 512 + col] * u; if (j == 3) raw = u; }
        x = x * sigmoidf_(x);
        if (cl < 64) QS[t * 64 + cl] = x * 0.125f; else KS[t * 64 + cl - 64] = x;
        if (t >= 1) a.out[O_CONVS + ((size_t)b * 3 + (t - 1)) * 512 + col] = raw;
        VS[t * 128 + cl] = bf2f(Z[(size_t)(rowb + t) * NZ + ZV + h * 128 + cl]);
    }
    __syncthreads();
    if (tid < 16) { const int t = tid >> 2, s = tid & 3; float d = 0.f;
#pragma unroll 8
        for (int e = 0; e < 64; ++e) d += QS[t * 64 + e] * KS[s * 64 + e];
        SR[tid] = d; }
    else if (tid < 20) { const int t = tid - 16; const float* n0 = a.in[5] + (size_t)unit * 64; float d = 0.f;
#pragma unroll 8
        for (int e = 0; e < 64; ++e) d += QS[t * 64 + e] * n0[e];
        QN[t] = d; }
    else if (tid >= 64 && tid < 128) { const int d = tid - 64; float nn = decay * a.in[5][(size_t)unit * 64 + d];
#pragma unroll
        for (int s = 0; s < 4; ++s) nn += wk[s] * KS[s * 64 + d];
        a.out[O_NS + (size_t)unit * 64 + d] = nn; }
    if (tid == 0) a.out[O_MS + unit] = mnew;
    {
        const int dg = tid >> 7, v = tid & 127;
        float* CN = a.out + O_CS + (size_t)unit * 8192;
        float vv[4], part[4] = {0.f, 0.f, 0.f, 0.f};
#pragma unroll
        for (int s = 0; s < 4; ++s) vv[s] = VS[s * 128 + v] * wk[s];
#pragma unroll
        for (int dd = 0; dd < 16; ++dd) { const int d = dg * 16 + dd; const float c = cs[dd]; float cn = decay * c;
#pragma unroll
            for (int s = 0; s < 4; ++s) { part[s] += QS[s * 64 + d] * c; cn += KS[s * 64 + d] * vv[s]; }
            CN[d * 128 + v] = cn; }
#pragma unroll
        for (int t = 0; t < 4; ++t) PART[(dg * 4 + t) * 128 + v] = part[t];
    }
    __syncthreads();
    {
        const int t = tid >> 7, v = tid & 127;
        const float Mtt = t == 0 ? Mt[0] : t == 1 ? Mt[1] : t == 2 ? Mt[2] : Mt[3];
        const float bct = t == 0 ? bc[0] : t == 1 ? bc[1] : t == 2 ? bc[2] : bc[3];
        const float winter = expf(m0 - Mtt);
        const float qC = PART[(0 * 4 + t) * 128 + v] + PART[(1 * 4 + t) * 128 + v] + PART[(2 * 4 + t) * 128 + v] + PART[(3 * 4 + t) * 128 + v];
        float num = winter * qC, den = winter * QN[t];
#pragma unroll
        for (int s = 0; s < 4; ++s) { const float w = (s <= t) ? SR[t * 4 + s] * expf(av[s] - Mtt) : 0.f; num += w * VS[s * 128 + v]; den += w; }
        const float hv = num / fmaxf(fabsf(den), expf(-(bct + Mtt)));
        const float ssw = wave_sum(hv * hv);
        if (lane == 0) RED[wave] = ssw;
        __syncthreads();
        const float tot = RED[2 * t] + RED[2 * t + 1];
        const float y = hv / sqrtf(tot * (1.f / 128.f) + EPS) * a.in[14][h * 128 + v] * sigmoidf_(bf2f(Z[(size_t)(rowb + t) * NZ + ZO + h * 128 + v]));
        YMIX[(size_t)(rowb + t) * DM + h * 128 + v] = (bf16)(pk2(y, 0.f) & 0xffffu);
    }
    __syncthreads();
}

__device__ __forceinline__ void swa_sample_prefetch(const Args& a, int unit, int tid, f32x4 (&kq)[4], f32x4 (&vq)[4]) {
    const int b = unit >> 1, kv = unit & 1;
#pragma unroll
    for (int i = 0; i < 4; ++i) { const int ch = tid + NTHR * i, j = ch >> 4, d4 = (ch & 15) * 4; const size_t o = (((size_t)b * 128 + j) * 2 + kv) * 64 + d4; kq[i] = *(const f32x4*)(a.in[8] + o); vq[i] = *(const f32x4*)(a.in[9] + o); }
}
__device__ __forceinline__ void swa_sample_unit(const Args& a, LAS unsigned char* lds, int unit, int tid, int lane, int wave, const f32x4 (&kq)[4], const f32x4 (&vq)[4]) {
    unsigned char* ws = a.ws;
    const bf16* Z = (const bf16*)(ws + WS_Z); float* ATTS = (float*)(ws + WS_ATTS);
    LAS float* KA = (LAS float*)lds; LAS float* VA = KA + 132 * 65; LAS float* QS = VA + 132 * 65; LAS float* SC = QS + 16 * 65;
    const int b = unit >> 1, kv = unit & 1, rowb = MP + b * 4;
    {
#pragma unroll
        for (int i = 0; i < 4; ++i) { const int ch = tid + NTHR * i, j = ch >> 4, d4 = (ch & 15) * 4;
#pragma unroll
            for (int e = 0; e < 4; ++e) { KA[j * 65 + d4 + e] = kq[i][e]; VA[j * 65 + d4 + e] = vq[i][e]; }
            if (j >= 4) { const size_t o = (((size_t)b * 128 + (j - 4)) * 2 + kv) * 64 + d4; *(f32x4*)(a.out + O_KS + o) = kq[i]; *(f32x4*)(a.out + O_VS + o) = vq[i]; } }
        if (tid < 256) { const int j = 128 + (tid >> 6), d = tid & 63; const size_t zo = (size_t)(rowb + j - 128) * NZ + kv * 64 + d; const float kk = bf2f(Z[zo + ZKA]), vv = bf2f(Z[zo + ZVA]);
            KA[j * 65 + d] = kk; VA[j * 65 + d] = vv; const size_t o = (((size_t)b * 128 + (j - 4)) * 2 + kv) * 64 + d; a.out[O_KS + o] = kk; a.out[O_VS + o] = vv; }
#pragma unroll
        for (int i = 0; i < 2; ++i) { const int idx = tid + NTHR * i, r = idx >> 6, d = idx & 63, g = r >> 2, t = r & 3;
            QS[r * 65 + d] = bf2f(Z[(size_t)(rowb + t) * NZ + ZQA + (kv * 4 + g) * 64 + d]); }
    }
    __syncthreads();
    { const int r = tid & 15, kk = tid >> 4, g = r >> 2, i = r & 3; const float slope = exp2f(-(float)(kv * 4 + g + 1));
#pragma unroll
      for (int jj = 0; jj < 5; ++jj) { const int key = kk + 32 * jj;
          if (key < 132) { float d = 0.f;
#pragma unroll 16
              for (int e = 0; e < 64; ++e) d += QS[r * 65 + e] * KA[key * 65 + e];
              const int dist = 128 + i - key; SC[r * 136 + key] = (dist >= 0 && dist <= 128) ? d * 0.125f - slope * (float)dist : -INFINITY; } } }
    __syncthreads();
    { const int r = tid >> 5, l = tid & 31, g = r >> 2; const float sink = a.in[15][kv * 4 + g];
      float sc[5]; float mx = sink;
#pragma unroll
      for (int jj = 0; jj < 5; ++jj) { const int key = l + 32 * jj; sc[jj] = key < 132 ? SC[r * 136 + key] : -INFINITY; mx = fmaxf(mx, sc[jj]); }
#pragma unroll
      for (int o = 1; o < 32; o <<= 1) mx = fmaxf(mx, __shfl_xor(mx, o));
      float sm = 0.f;
#pragma unroll
      for (int jj = 0; jj < 5; ++jj) { sc[jj] = expf(sc[jj] - mx); sm += sc[jj]; }
#pragma unroll
      for (int o = 1; o < 32; o <<= 1) sm += __shfl_xor(sm, o);
      const float inv = 1.f / (sm + expf(sink - mx));
#pragma unroll
      for (int jj = 0; jj < 5; ++jj) { const int key = l + 32 * jj; if (key < 132) SC[r * 136 + key] = sc[jj] * inv; } }
    __syncthreads();
    { const int r = tid >> 5, d = (tid & 31) * 2, g = r >> 2, i = r & 3; float o0 = 0.f, o1 = 0.f;
#pragma unroll 12
      for (int s = 0; s < 132; ++s) { const float p = SC[r * 136 + s]; o0 += p * VA[s * 65 + d]; o1 += p * VA[s * 65 + d + 1]; }
      float* op = ATTS + (size_t)(b * 4 + i) * 512 + (kv * 4 + g) * 64 + d; op[0] = o0; op[1] = o1; }
    __syncthreads();
}
__device__ __forceinline__ void swa_sample_norm(const Args& a, int lane, int wave) {
    unsigned char* ws = a.ws; const float* ATTS = (const float*)(ws + WS_ATTS); bf16* YMIX = (bf16*)(ws + WS_ACTA);
    const int gw = blockIdx.x * NWAVES + wave, NGW = gridDim.x * NWAVES;
    for (int r = gw; r < MS; r += NGW) {
        const f32x4 v0 = *(const f32x4*)(ATTS + (size_t)r * 512 + 8 * lane), v1 = *(const f32x4*)(ATTS + (size_t)r * 512 + 8 * lane + 4);
        const float ss = wave_sum((v0[0] * v0[0] + v0[1] * v0[1]) + (v0[2] * v0[2] + v0[3] * v0[3]) + (v1[0] * v1[0] + v1[1] * v1[1]) + (v1[2] * v1[2] + v1[3] * v1[3]));
        const float rn = 1.f / sqrtf(ss * (1.f / 512.f) + EPS);
        const f32x4 g0 = *(const f32x4*)(a.in[16] + 8 * lane), g1 = *(const f32x4*)(a.in[16] + 8 * lane + 4);
        u32x4 o; o.x = pk2(v0[0] * rn * g0[0], v0[1] * rn * g0[1]); o.y = pk2(v0[2] * rn * g0[2], v0[3] * rn * g0[3]); o.z = pk2(v1[0] * rn * g1[0], v1[1] * rn * g1[1]); o.w = pk2(v1[2] * rn * g1[2], v1[3] * rn * g1[3]);
        *(u32x4*)(YMIX + (size_t)(MP + r) * DM + 512 + 8 * lane) = o;
    }
}

__device__ __forceinline__ void misc_outputs(const Args& a, int tid) {
    const bf16* Z = (const bf16*)(a.ws + WS_Z);
    const int gt = blockIdx.x * NTHR + tid, NT = gridDim.x * NTHR;
    for (int i = gt; i < 2 * 128 * 128; i += NT) { const int b = i >> 14, j = (i >> 7) & 127, cidx = i & 127; const size_t zr = (size_t)(b * SEQ + SEQ - 128 + j) * NZ;
        a.out[O_KP + i] = bf2f(Z[zr + ZKA + cidx]); a.out[O_VP + i] = bf2f(Z[zr + ZVA + cidx]); }
    for (int i = gt; i < 2 * 3 * 512; i += NT) { const int b = i / 1536, j = (i / 512) % 3, cidx = i & 511;
        a.out[O_CONVP + i] = bf2f(Z[(size_t)(b * SEQ + SEQ - 3 + j) * NZ + ZQK + cidx]); }
}

__device__ __forceinline__ bf16* d1_row(unsigned char* ws, int m) { return m < MP ? (bf16*)(ws + WS_D1P) + (size_t)m * DM : (bf16*)(ws + WS_D1S) + (size_t)(m - MP) * DM; }
__device__ __forceinline__ void rowpass_mix(const Args& a, int lane, int wave) {
    unsigned char* ws = a.ws; const bf16* MIXS = (const bf16*)(ws + WS_MIXS); bf16* U = (bf16*)(ws + WS_ACTA);
    const int gw = blockIdx.x * NWAVES + wave, NGW = gridDim.x * NWAVES;
    f32x4 gp[4], gf[4];
#pragma unroll
    for (int j = 0; j < 2; ++j) { const int c0 = 8 * lane + 512 * j; gp[2 * j] = *(const f32x4*)(a.in[18] + c0); gp[2 * j + 1] = *(const f32x4*)(a.in[18] + c0 + 4); gf[2 * j] = *(const f32x4*)(a.in[19] + c0); gf[2 * j + 1] = *(const f32x4*)(a.in[19] + c0 + 4); }
    for (int grp = MP / 4 + gw; grp < MT / 4; grp += NGW) {
        u32x4 mw[4][2]; f32x4 xv[4][4];
#pragma unroll
        for (int r = 0; r < 4; ++r) { const int m = grp * 4 + r; const float* xr = m < MP ? a.in[0] + (size_t)m * DM : a.in[1] + (size_t)(m - MP) * DM;
#pragma unroll
            for (int j = 0; j < 2; ++j) { const int c0 = 8 * lane + 512 * j; mw[r][j] = *(const u32x4*)(MIXS + (size_t)(m - MP) * DM + c0); xv[r][2 * j] = *(const f32x4*)(xr + c0); xv[r][2 * j + 1] = *(const f32x4*)(xr + c0 + 4); } }
#pragma unroll
        for (int r = 0; r < 4; ++r) { const int m = grp * 4 + r;
            f32x4 mv[4]; float s = 0.f;
#pragma unroll
            for (int j = 0; j < 2; ++j) { mv[2 * j] = (f32x4){bflo(mw[r][j][0]), bfhi(mw[r][j][0]), bflo(mw[r][j][1]), bfhi(mw[r][j][1])}; mv[2 * j + 1] = (f32x4){bflo(mw[r][j][2]), bfhi(mw[r][j][2]), bflo(mw[r][j][3]), bfhi(mw[r][j][3])}; }
#pragma unroll
            for (int q = 0; q < 4; ++q) s += (mv[q][0] * mv[q][0] + mv[q][1] * mv[q][1]) + (mv[q][2] * mv[q][2] + mv[q][3] * mv[q][3]);
            const float rs = 1.f / sqrtf(wave_sum(s) * (1.f / DM) + EPS);
            float s1 = 0.f;
#pragma unroll
            for (int q = 0; q < 4; ++q) { mv[q] = mv[q] * gp[q] * rs; xv[r][q] = xv[r][q] + mv[q]; s1 += (xv[r][q][0] * xv[r][q][0] + xv[r][q][1] * xv[r][q][1]) + (xv[r][q][2] * xv[r][q][2] + xv[r][q][3] * xv[r][q][3]); }
            const float rs1 = 1.f / sqrtf(wave_sum(s1) * (1.f / DM) + EPS);
#pragma unroll
            for (int j = 0; j < 2; ++j) { const int c0 = 8 * lane + 512 * j;
                { u32x4 dd; dd.x = pk2(xv[r][2 * j][0], xv[r][2 * j][1]); dd.y = pk2(xv[r][2 * j][2], xv[r][2 * j][3]); dd.z = pk2(xv[r][2 * j + 1][0], xv[r][2 * j + 1][1]); dd.w = pk2(xv[r][2 * j + 1][2], xv[r][2 * j + 1][3]);
                  *(u32x4*)(d1_row(ws, m) + c0) = dd; }
                const f32x4 u0 = xv[r][2 * j] * gf[2 * j] * rs1, u1 = xv[r][2 * j + 1] * gf[2 * j + 1] * rs1;
                u32x4 o; o.x = pk2(u0[0], u0[1]); o.y = pk2(u0[2], u0[3]); o.z = pk2(u1[0], u1[1]); o.w = pk2(u1[2], u1[3]);
                *(u32x4*)(U + (size_t)m * DM + c0) = o; }
        }
    }
}
__device__ __forceinline__ void rowpass_ffn(const Args& a, int lane, int wave) {
    unsigned char* ws = a.ws; bf16* Fb = (bf16*)(ws + WS_ACTA);
    const int gw = blockIdx.x * NWAVES + wave, NGW = gridDim.x * NWAVES;
    f32x4 gp[4];
#pragma unroll
    for (int j = 0; j < 2; ++j) { const int c0 = 8 * lane + 512 * j; gp[2 * j] = *(const f32x4*)(a.in[22] + c0); gp[2 * j + 1] = *(const f32x4*)(a.in[22] + c0 + 4); }
    for (int grp = MP / 4 + gw; grp < MT / 4; grp += NGW) {
        u32x4 fw[4][2], dw[4][2];
#pragma unroll
        for (int r = 0; r < 4; ++r) { const int m = grp * 4 + r; const bf16* dr = d1_row(ws, m);
#pragma unroll
            for (int j = 0; j < 2; ++j) { const int c0 = 8 * lane + 512 * j; fw[r][j] = *(const u32x4*)(Fb + (size_t)m * DM + c0); dw[r][j] = *(const u32x4*)(dr + c0); } }
#pragma unroll
        for (int r = 0; r < 4; ++r) { const int m = grp * 4 + r;
            f32x4 fv[4]; float s = 0.f;
#pragma unroll
            for (int j = 0; j < 2; ++j) { fv[2 * j] = (f32x4){bflo(fw[r][j][0]), bfhi(fw[r][j][0]), bflo(fw[r][j][1]), bfhi(fw[r][j][1])}; fv[2 * j + 1] = (f32x4){bflo(fw[r][j][2]), bfhi(fw[r][j][2]), bflo(fw[r][j][3]), bfhi(fw[r][j][3])}; }
#pragma unroll
            for (int q = 0; q < 4; ++q) s += (fv[q][0] * fv[q][0] + fv[q][1] * fv[q][1]) + (fv[q][2] * fv[q][2] + fv[q][3] * fv[q][3]);
            const float rs = 1.f / sqrtf(wave_sum(s) * (1.f / DM) + EPS);
#pragma unroll
            for (int j = 0; j < 2; ++j) { const int c0 = 8 * lane + 512 * j;
                const f32x4 d0 = {bflo(dw[r][j][0]), bfhi(dw[r][j][0]), bflo(dw[r][j][1]), bfhi(dw[r][j][1])}, d1 = {bflo(dw[r][j][2]), bfhi(dw[r][j][2]), bflo(dw[r][j][3]), bfhi(dw[r][j][3])};
                const f32x4 x0 = d0 + fv[2 * j] * gp[2 * j] * rs, x1 = d1 + fv[2 * j + 1] * gp[2 * j + 1] * rs;
                u32x4 o; o.x = pk2(x0[0], x0[1]); o.y = pk2(x0[2], x0[3]); o.z = pk2(x1[0], x1[1]); o.w = pk2(x1[2], x1[3]);
                *(u32x4*)((bf16*)(ws + WS_X2) + (size_t)m * DM + c0) = o; }
        }
    }
}
struct SkBf16 { bf16* O; int ldc; int act;
    __device__ __forceinline__ void operator()(int row, int col, f32x4 v) const {
        if (act == 2) {
#pragma unroll
            for (int e = 0; e < 4; ++e) { const float t = v[e] > 0.f ? v[e] : 0.f; v[e] = t * t; } }
        u32x2 o; o.x = pk2(v[0], v[1]); o.y = pk2(v[2], v[3]); *(u32x2*)(O + (size_t)row * ldc + col) = o; } };
struct SkFinal { float* out; const bf16* PP; const bf16* X2;
    __device__ __forceinline__ void operator()(int row, int col, f32x4 v) const {
        const size_t o = (size_t)row * DM + col; const u32x2 xw = *(const u32x2*)(X2 + o); const f32x4 xs = {bflo(xw.x), bfhi(xw.x), bflo(xw.y), bfhi(xw.y)}; const u32x2 pw = *(const u32x2*)(PP + o);
        f32x4 r; r[0] = xs[0] + bflo(pw.x) * sigmoidf_(v[0]); r[1] = xs[1] + bfhi(pw.x) * sigmoidf_(v[1]); r[2] = xs[2] + bflo(pw.y) * sigmoidf_(v[2]); r[3] = xs[3] + bfhi(pw.y) * sigmoidf_(v[3]);
        *(f32x4*)(out + o) = r; } };
struct SkNormX { float* xbuf; unsigned* cnt; const bf16* X1; const float* g; bf16* X2; };
__device__ __forceinline__ void skinny_norm_epilogue(const SkNormX& nx, LAS float* SSQ  , LAS float* RS  , int r0, int c0, int rloc, int col, f32x4 v, int tid, int lane, int wave) {
    const int rb = r0 >> 6, cb = c0 >> 5;
    SSQ[128 + rloc * 8 + (((col - c0) >> 2) & 7)] = (v[0] * v[0] + v[1] * v[1]) + (v[2] * v[2] + v[3] * v[3]);
    __syncthreads();
    if (tid < 64) { const LAS float* pp = SSQ + 128 + tid * 8; const float t = ((pp[0] + pp[1]) + (pp[2] + pp[3])) + ((pp[4] + pp[5]) + (pp[6] + pp[7]));
        __hip_atomic_store(nx.xbuf + ((size_t)(rb * 64 + tid) * 32 + cb), t, __ATOMIC_RELAXED, __HIP_MEMORY_SCOPE_AGENT); }
    if (wave == 0) { asm volatile("s_waitcnt vmcnt(0)" ::: "memory");
        if (lane == 0) __hip_atomic_fetch_add(nx.cnt + 64 * rb, 1u, __ATOMIC_RELAXED, __HIP_MEMORY_SCOPE_AGENT);
        unsigned sp = 0u;
        for (;;) { if ((unsigned)__builtin_amdgcn_readfirstlane(__hip_atomic_load(nx.cnt + 64 * rb, __ATOMIC_RELAXED, __HIP_MEMORY_SCOPE_AGENT)) >= 32u) break;
            if (++sp > (1u << 21)) break;
            __builtin_amdgcn_s_sleep(2); }
        __builtin_amdgcn_fence(__ATOMIC_ACQUIRE, "agent"); }
    asm volatile("s_waitcnt vmcnt(0) lgkmcnt(0)" ::: "memory"); __syncthreads();
    { const int row = tid >> 3, part = tid & 7; const float* slot = nx.xbuf + (size_t)(rb * 64 + row) * 32 + part * 4; float t = 0.f;
#pragma unroll
      for (int q = 0; q < 4; ++q) t += __hip_atomic_load(slot + q, __ATOMIC_RELAXED, __HIP_MEMORY_SCOPE_AGENT);
      t += __shfl_xor(t, 1); t += __shfl_xor(t, 2); t += __shfl_xor(t, 4);
      if (part == 0) RS[row] = 1.f / sqrtf(t * (1.f / 1024.f) + EPS); }
    __syncthreads();
    const float rs = RS[rloc];
    const size_t o = (size_t)(r0 + rloc) * DM + col; const u32x2 xw = *(const u32x2*)(nx.X1 + o); const f32x4 g4 = *(const f32x4*)(nx.g + col);
    u32x2 w; w.x = pk2(bflo(xw.x) + v[0] * rs * g4[0], bfhi(xw.x) + v[1] * rs * g4[1]); w.y = pk2(bflo(xw.y) + v[2] * rs * g4[2], bfhi(xw.y) + v[3] * rs * g4[3]);
    *(u32x2*)(nx.X2 + o) = w;
}
template <int KC, class Epi>
__device__ __forceinline__ void skinny_gemm(LAS unsigned char* lds, const bf16* A, const bf16* Bt, int N, int K, const Epi& E, int tid, int lane, int wave, int first = -1, int stride = 0) {
    constexpr int PITCH = KC * 2 + 16, APC = KC / 8, NA = 64 * APC / NTHR, NB = 32 * APC / NTHR, STEPS = KC / 128;
    LAS unsigned char* AS = lds; LAS unsigned char* BS = lds + 64 * PITCH;
    LAS float* PART = (LAS float*)lds;
    const int ntiles = 8 * (N / 32), l32 = lane & 31, hi = lane >> 5, nch = K / KC;
    if (first < 0) { first = blockIdx.x; stride = gridDim.x; }
    for (int tile = first; tile < ntiles; tile += stride) {
        int r0 = (tile & 7) * 64, c0 = (tile >> 3) * 32;
        if (stride == 256) { const int bxx = tile & 255, it = tile >> 8; r0 = ((bxx >> 3) & 7) * 64; c0 = (it * 32 + (bxx >> 6) * 8 + (bxx & 7)) * 32; }
        f32x16 acc0 = {}, acc1 = {};
        u32x4 ra[NA], rb[NB];
#define SK_LOADG(chk) do { \
        _Pragma("unroll") for (int i = 0; i < NA; ++i) { const int p = tid + NTHR * i, row = p / APC, pc = p % APC; ra[i] = *(const u32x4*)(A + (size_t)(r0 + row) * K + (chk) * KC + pc * 8); } \
        _Pragma("unroll") for (int i = 0; i < NB; ++i) { const int p = tid + NTHR * i, row = p / APC, pc = p % APC; rb[i] = *(const u32x4*)(Bt + (size_t)(c0 + row) * K + (chk) * KC + pc * 8); } } while (0)
        SK_LOADG(0);
        for (int ch = 0; ch < nch; ++ch) {
#pragma unroll
            for (int i = 0; i < NA; ++i) { const int p = tid + NTHR * i, row = p / APC, pc = p % APC; *(LAS u32x4*)(AS + row * PITCH + pc * 16) = ra[i]; }
#pragma unroll
            for (int i = 0; i < NB; ++i) { const int p = tid + NTHR * i, row = p / APC, pc = p % APC; *(LAS u32x4*)(BS + row * PITCH + pc * 16) = rb[i]; }
            if (ch + 1 < nch) SK_LOADG(ch + 1);
            __syncthreads();
#pragma unroll
            for (int s = 0; s < STEPS; ++s) { const int koff = (wave * (KC / 8) + s * 16 + 8 * hi) * 2;
                const bf16x8 b = *(const LAS bf16x8*)(BS + l32 * PITCH + koff), a0 = *(const LAS bf16x8*)(AS + l32 * PITCH + koff), a1 = *(const LAS bf16x8*)(AS + (32 + l32) * PITCH + koff);
                acc0 = __builtin_amdgcn_mfma_f32_32x32x16_bf16(b, a0, acc0, 0, 0, 0); acc1 = __builtin_amdgcn_mfma_f32_32x32x16_bf16(b, a1, acc1, 0, 0, 0); }
            __syncthreads();
        }
#undef SK_LOADG
#pragma unroll
        for (int r = 0; r < 16; ++r) { PART[((wave * 2 + 0) * 16 + r) * 64 + lane] = acc0[r]; PART[((wave * 2 + 1) * 16 + r) * 64 + lane] = acc1[r]; }
        __syncthreads();
        { const int i = tid >> 8, rq = (tid >> 6) & 3, ln = tid & 63; f32x4 v = {0.f, 0.f, 0.f, 0.f};
#pragma unroll
          for (int w = 0; w < 8; ++w)
#pragma unroll
              for (int e = 0; e < 4; ++e) v[e] += PART[((w * 2 + i) * 16 + 4 * rq + e) * 64 + ln];
          if constexpr (__is_same(Epi, SkNormX)) { LAS float* SSQ = (LAS float*)(lds + 65536); LAS float* RS = SSQ + 64;
              skinny_norm_epilogue(E, SSQ, RS, r0, c0, 32 * i + (ln & 31), c0 + 8 * rq + 4 * (ln >> 5), v, tid, lane, wave); }
          else E(r0 + 32 * i + (ln & 31), c0 + 8 * rq + 4 * (ln >> 5), v); }
        __syncthreads();
    }
}

template <class Epi>
__device__ __forceinline__ void skinny_gemm128(LAS unsigned char* lds, const bf16* A, const bf16* Bt, int N, int K, const Epi& E, int tid, int lane, int wave, int first = -1, int stride = 0) {
    constexpr int KC = 256, PITCH = KC * 2 + 16, APC = KC / 8, NA = 128 * APC / NTHR, NB = 64 * APC / NTHR;
    LAS unsigned char* AS = lds; LAS unsigned char* BS = lds + 128 * PITCH;
    const int ntiles = 4 * (N / 64), l32 = lane & 31, hi = lane >> 5, nch = K / KC, rbk = wave >> 1, cbk = wave & 1;
    if (first < 0) { first = blockIdx.x; stride = gridDim.x; }
    for (int tile = first; tile < ntiles; tile += stride) {
        const int r0 = (tile & 3) * 128, c0 = (tile >> 2) * 64;
        f32x16 acc = {};
        u32x4 ra[NA], rb[NB];
#define SK_LOADG(chk) do { \
        _Pragma("unroll") for (int i = 0; i < NA; ++i) { const int p = tid + NTHR * i, row = p / APC, pc = p % APC; ra[i] = *(const u32x4*)(A + (size_t)(r0 + row) * K + (chk) * KC + pc * 8); } \
        _Pragma("unroll") for (int i = 0; i < NB; ++i) { const int p = tid + NTHR * i, row = p / APC, pc = p % APC; rb[i] = *(const u32x4*)(Bt + (size_t)(c0 + row) * K + (chk) * KC + pc * 8); } } while (0)
        SK_LOADG(0);
        for (int ch = 0; ch < nch; ++ch) {
#pragma unroll
            for (int i = 0; i < NA; ++i) { const int p = tid + NTHR * i, row = p / APC, pc = p % APC; *(LAS u32x4*)(AS + row * PITCH + pc * 16) = ra[i]; }
#pragma unroll
            for (int i = 0; i < NB; ++i) { const int p = tid + NTHR * i, row = p / APC, pc = p % APC; *(LAS u32x4*)(BS + row * PITCH + pc * 16) = rb[i]; }
            if (ch + 1 < nch) SK_LOADG(ch + 1);
            __syncthreads();
#pragma unroll
            for (int s = 0; s < KC / 16; ++s) { const int koff = (s * 16 + 8 * hi) * 2;
                const bf16x8 b = *(const LAS bf16x8*)(BS + (cbk * 32 + l32) * PITCH + koff), a = *(const LAS bf16x8*)(AS + (rbk * 32 + l32) * PITCH + koff);
                acc = __builtin_amdgcn_mfma_f32_32x32x16_bf16(b, a, acc, 0, 0, 0); }
            __syncthreads();
        }
#undef SK_LOADG
#pragma unroll
        for (int rg = 0; rg < 4; ++rg) E(r0 + rbk * 32 + l32, c0 + cbk * 32 + 8 * rg + 4 * hi, (f32x4){acc[4 * rg], acc[4 * rg + 1], acc[4 * rg + 2], acc[4 * rg + 3]});
    }
}
constexpr int N_PHASES = 11;
__global__ void __launch_bounds__(NTHR) hymba_fwd(Args args) {
    extern __shared__ __attribute__((aligned(16))) unsigned char lds_raw[];
    LAS unsigned char* lds = (LAS unsigned char*)lds_raw;
    const int tid = threadIdx.x, lane = tid & 63, wave = __builtin_amdgcn_readfirstlane(tid >> 6);
    const int G = gridDim.x, bx = blockIdx.x;
    unsigned char* ws = args.ws;
    const int lo = args.ph_lo, hi = args.ph_hi;
#ifndef PHMASK
#define PHMASK 0x7ff
#endif
#define IN(k) (((PHMASK >> (k)) & 1) && lo <= (k) && (k) < hi)
    if (tid < 256) ((LAS unsigned*)(lds + 131072))[tid] = 0u;
    __syncthreads();
    XcdBarrier bar; bar.bar = (unsigned*)(ws + WS_CTL); bar.x = 0; bar.st = nullptr;
    if (args.coop) bar = xcd_barrier_post((unsigned*)(ws + WS_CTL), (volatile LAS unsigned*)(lds + MISC_OFF) + 8);
    if (args.pad == 0x5a5a) cg::this_grid().sync();
#define SEAM(k) do { if (args.coop && IN((k) + 1)) { xcd_barrier(bar); } } while (0)
    bf16* ACTA = (bf16*)(ws + WS_ACTA);
    if (IN(0)) { p0_prologue(args, lds, tid, lane, wave); SEAM(0); }
    if (IN(1)) {
        const int skf = (G == 256) ? (bx >= 64 ? bx - 64 : (1 << 28)) : bx, sks = (G == 256) ? 192 : G;
        { SkBf16 E{(bf16*)(ws + WS_Z) + (size_t)MP * NZ, NZ, 0}; skinny_gemm<512>(lds, ACTA + (size_t)MP * DM, (const bf16*)(ws + WS_WIN), NZ, DM, E, tid, lane, wave, skf, sks); }
        { SkBf16 E{(bf16*)(ws + WS_PP) + (size_t)MP * DM, DM, 0}; skinny_gemm<256>(lds, (const bf16*)(ws + WS_PBF) + (size_t)MP * PD, (const bf16*)(ws + WS_WPP), DM, PD, E, tid, lane, wave, skf, sks); }
        { pg8::Gemm g{ACTA, (const bf16*)(ws + WS_WIN), MP, NZ, DM}; pg8::StaticOrder S; S.init(MP, NZ, G, bx);
          pg8::EpiBf16<0> E{(bf16*)(ws + WS_Z), NZ};
          pg8::gemm_phase<pg8::EpiBf16<0>, pg8::StaticOrder, true, true>(lds, g, S, E); }
        { pg8::Gemm g{(const bf16*)(ws + WS_PBF), (const bf16*)(ws + WS_WPP), MP, DM, PD}; pg8::StaticOrder S; S.init(MP, DM, 192, bx >= 64 ? bx - 64 : 1 << 20);
          pg8::EpiBf16<0> E{(bf16*)(ws + WS_PP), DM};
          pg8::gemm_phase<pg8::EpiBf16<0>, pg8::StaticOrder, true, true>(lds, g, S, E); }
        SEAM(1);
    }
    if (IN(2)) {
        if (G == 256) {
            float cs0[16], cs1[16]; f32x4 kq[4], vq[4];
            mlstm_sample_prefetch(args, bx, tid, cs0); mlstm_sample_prefetch(args, bx + 256, tid, cs1); swa_sample_prefetch(args, bx, tid, kq, vq);
            mlstm_b1_unit(args, lds, bx, tid, lane, wave); mlstm_b1_unit(args, lds, bx + 256, tid, lane, wave);
            mlstm_sample_unit(args, lds, bx, tid, lane, wave, cs0); mlstm_sample_unit(args, lds, bx + 256, tid, lane, wave, cs1);
            swa_sample_unit(args, lds, bx, tid, lane, wave, kq, vq);
        } else {
            for (int u = bx; u < 512; u += G) mlstm_b1_unit(args, lds, u, tid, lane, wave);
            for (int u = bx; u < 512; u += G) { float cs0[16]; mlstm_sample_prefetch(args, u, tid, cs0); mlstm_sample_unit(args, lds, u, tid, lane, wave, cs0); }
            for (int u = bx; u < 256; u += G) { f32x4 kq[4], vq[4]; swa_sample_prefetch(args, u, tid, kq, vq); swa_sample_unit(args, lds, u, tid, lane, wave, kq, vq); }
        }
        SEAM(2);
    }
    if (IN(3)) {
        if (!(args.pad & 1)) mlstm_scan(args, tid);
        if (G == 256 && bx < 128) { transpose_items(args, lds, IT_EARLY, IT_EARLY + 1024, bx * NWAVES + wave, 128 * NWAVES, lane, wave); __syncthreads(); }
        else if (bx >= 129) { const int t0 = (G == 256) ? IT_EARLY + 1024 : IT_EARLY; transpose_items(args, lds, t0, IT_ALL, (bx - 129) * NWAVES + wave, (G - 129) * NWAVES, lane, wave); __syncthreads(); }
        if (!(args.pad & 2)) {
            if (G == 256) {
                const int vcu = (bx & 7) * 32 + (bx >> 3);
                swa_prompt_unit(args, lds, 2 * vcu, tid, lane, wave); swa_prompt_unit(args, lds, 2 * vcu + 1, tid, lane, wave);
            } else for (int u = bx; u < 512; u += G) swa_prompt_unit(args, lds, u, tid, lane, wave);
        }
        if (!(args.pad & 4)) { misc_outputs(args, tid); swa_sample_norm(args, lane, wave); }
        SEAM(3);
    }
    if (IN(4)) {
        for (int u = 2 * bx; u < 512; u += 2 * G) mlstm_b3_pair(args, lds, u, tid, lane, wave);
        { SkBf16 E{(bf16*)(ws + WS_MIXS), DM, 0}; skinny_gemm<512>(lds, ACTA + (size_t)MP * DM, (const bf16*)(ws + WS_WOUT), DM, DM, E, tid, lane, wave); }
        SEAM(4);
    }
    if (IN(5)) {
        rowpass_mix(args, lane, wave);
        pg8::Gemm g{ACTA, (const bf16*)(ws + WS_WOUT), MP, DM, DM}; pg8::StaticOrder S; S.init(MP, DM, G, bx);
        unsigned* cb = (unsigned*)(ws + WS_CTL + 16384); float* xb = (float*)(ws + WS_XBUF);
        pg8::EpiMixNorm E{args.in[18], args.in[19], (bf16*)(ws + WS_D1P), ACTA, DM, EPS, pg8::RowSumSq{xb, cb}, pg8::RowSumSq{xb + 65536, cb + 4096}};
        pg8::gemm_phase<pg8::EpiMixNorm, pg8::StaticOrder, false, true>(lds, g, S, E);
        SEAM(6);
    }
    if (IN(7)) {
        { SkBf16 E2{(bf16*)(ws + WS_H) + (size_t)MP * FF, FF, 2}; skinny_gemm128(lds, ACTA + (size_t)MP * DM, (const bf16*)(ws + WS_WUP), FF, DM, E2, tid, lane, wave); }
        pg8::Gemm g{ACTA, (const bf16*)(ws + WS_WUP), MP, FF, DM}; pg8::StaticOrder S; S.init(MP, FF, G, bx);
        pg8::EpiBf16<2> E{(bf16*)(ws + WS_H), FF};
        pg8::gemm_phase<pg8::EpiBf16<2>, pg8::StaticOrder, true, true>(lds, g, S, E);
        SEAM(7);
    }
    if (IN(8)) {
        { SkNormX E2{(float*)(ws + WS_XBUF) + 196608, (unsigned*)(ws + WS_CTL + 16384) + 12288, (const bf16*)(ws + WS_D1S), args.in[22], ACTA + (size_t)MP * DM};
          skinny_gemm<512>(lds, (const bf16*)(ws + WS_H) + (size_t)MP * FF, (const bf16*)(ws + WS_WDN), DM, FF, E2, tid, lane, wave); }
        pg8::Gemm g{(const bf16*)(ws + WS_H), (const bf16*)(ws + WS_WDN), MP, DM, FF}; pg8::StaticOrder S; S.init(MP, DM, G, bx);
        pg8::EpiFfnNorm E{(const bf16*)(ws + WS_D1P), args.in[22], ACTA, DM, EPS, pg8::RowSumSq{(float*)(ws + WS_XBUF) + 131072, (unsigned*)(ws + WS_CTL + 16384) + 8192}};
        pg8::gemm_phase<pg8::EpiFfnNorm, pg8::StaticOrder, false, true>(lds, g, S, E);
        SEAM(9);
    }
    if (IN(10)) {
        const bf16* X2 = ACTA;
        { SkFinal E{args.out + (size_t)MP * DM, (const bf16*)(ws + WS_PP) + (size_t)MP * DM, X2 + (size_t)MP * DM}; skinny_gemm<512>(lds, X2 + (size_t)MP * DM, (const bf16*)(ws + WS_WPG), DM, DM, E, tid, lane, wave); }
        pg8::Gemm g{X2, (const bf16*)(ws + WS_WPG), MP, DM, DM}; pg8::StaticOrder S; S.init(MP, DM, G, bx);
        pg8::EpiFinal E{args.out, (const bf16*)(ws + WS_PP), X2, DM};
        pg8::gemm_phase<pg8::EpiFinal, pg8::StaticOrder, true, true>(lds, g, S, E);
    }
#undef IN
#undef SEAM
}

#ifndef REP_MASK
#define REP_MASK 0
#endif
#ifndef REP_SKIP
#define REP_SKIP 0
#endif
#ifndef MK_SINGLE
#define MK_SINGLE 1
#endif
extern "C" void kernel_launch(void* const* d_in, const int* in_sizes, int n_in, void* d_out, int out_size, void* d_ws, size_t ws_size, hipStream_t stream) {
    static int grid = 0;
    if (grid == 0) {
        if (n_in != 25 || out_size != (int)O_END || ws_size < WS_END) { fprintf(stderr, "kernel_launch: unexpected shapes: n_in %d out %d ws %zu\n", n_in, out_size, ws_size); grid = -1; return; }
        int dev = 0, cus = 0, per_cu = 0;
        hipGetDevice(&dev); hipDeviceGetAttribute(&cus, hipDeviceAttributeMultiprocessorCount, dev);
        if (hipFuncSetAttribute((const void*)hymba_fwd, hipFuncAttributeMaxDynamicSharedMemorySize, LDS_BYTES) != hipSuccess) { fprintf(stderr, "kernel_launch: hipFuncSetAttribute failed\n"); grid = -1; return; }
        hipOccupancyMaxActiveBlocksPerMultiprocessor(&per_cu, (const void*)hymba_fwd, NTHR, LDS_BYTES);
        (void)hipGetLastError();
        if (per_cu < 1) per_cu = 1;
        grid = cus * 1;
        fprintf(stderr, "kernel_launch: cus %d per_cu %d grid %d\n", cus, per_cu, grid);
    }
    if (grid < 0) return;
    if (hipMemsetAsync((char*)d_ws + WS_CTL, 0, CTL_BYTES, stream) != hipSuccess) { fprintf(stderr, "kernel_launch: memset failed\n"); return; }
    Args a{};
    for (int i = 0; i < 25; ++i) a.in[i] = (const float*)d_in[i];
    a.out = (float*)d_out; a.ws = (unsigned char*)d_ws;
#if MK_SINGLE
    a.ph_lo = 0; a.ph_hi = N_PHASES; a.coop = 1;
    void* kargs[] = {&a};
    hipError_t e = hipLaunchCooperativeKernel((const void*)hymba_fwd, dim3(grid), dim3(NTHR), kargs, LDS_BYTES, stream);
    if (e != hipSuccess) fprintf(stderr, "cooperative launch failed: %s (grid %d)\n", hipGetErrorString(e), grid);
#else
    for (int p = 0; p < N_PHASES; ++p) { a.ph_lo = p; a.ph_hi = p + 1; a.coop = 0;
        for (int r = 0; r < (((REP_MASK >> p) & 1) ? 2 : 1); ++r) { a.pad = r ? REP_SKIP : 0; hipLaunchKernelGGL(hymba_fwd, dim3(grid), dim3(NTHR), LDS_BYTES, stream, a); } }
#endif
}
```

```cpp
#include <hip/hip_runtime.h>
#include <hip/hip_cooperative_groups.h>
#include <cstdio>
#include <cstdint>
namespace cg = cooperative_groups;
namespace pg8 {
#define PG8_LAS __attribute__((address_space(3)))
typedef unsigned short bf16_t;
typedef short bf16x8 __attribute__((ext_vector_type(8)));
typedef float f32x4 __attribute__((ext_vector_type(4)));
typedef unsigned u32x4 __attribute__((ext_vector_type(4)));
constexpr int BM = 256, BK = 64, HALF = 128, HTB = HALF * BK * 2  , STAGE_BYTES = 8 * HTB, NXCD = 8, WGM = 8;

__host__ __device__ __forceinline__ int lds_byte(int r, int c) { const int st = (r >> 4) * 2 + (c >> 5), rr = r & 15, cc = c & 31, ob = rr * 64 + cc * 2; return st * 1024 + (ob ^ (((ob >> 9) & 1) << 5)); }
__host__ __device__ __forceinline__ void stage_rc(int b, int& R, int& C) { const int st = b / 1024, sb = b % 1024, swz = sb ^ (((sb >> 9) & 1) << 5); R = (st >> 1) * 16 + swz / 64; C = (st & 1) * 32 + (swz % 64) / 2; }
__host__ __device__ __forceinline__ int perm32(int rho) { const int n = rho >> 4, i = rho & 15; return 8 * (i >> 2) + 4 * n + (i & 3); }

struct Unit { int pm, pn; };
struct Gemm { const bf16_t* A; const bf16_t* Bt; int M, N, K; };

struct StaticOrder {
    int nM, nN, nwg, G, c;
    __host__ __device__ void init(int M, int N, int G_, int c_) { nM = M / BM; nN = N / BM; nwg = nM * nN; G = G_; c = c_; }
    __host__ __device__ bool next(int i, Unit& u) const {
        const long L = (long)i * G + c; if (L >= nwg) return false;
        int wgid = (int)L; { const int q = nwg / NXCD, r = nwg % NXCD, xcd = wgid % NXCD, off = wgid / NXCD; wgid = (xcd < r ? xcd * (q + 1) : r * (q + 1) + (xcd - r) * q) + off; }
        const int nig = WGM * nN, gid = wgid / nig, fm = gid * WGM, gsz = (nM - fm) < WGM ? (nM - fm) : WGM;
        u.pm = fm + ((wgid % nig) % gsz); u.pn = (wgid % nig) / gsz; return true;
    }
    __device__ __forceinline__ void a_ready(const Unit&) const {}
    __device__ __forceinline__ void done(const Unit&) const {}
};

__device__ __forceinline__ unsigned cvt_pk_bf16(float lo, float hi) { unsigned r; asm volatile("v_cvt_pk_bf16_f32 %0, %1, %2" : "=v"(r) : "v"(lo), "v"(hi)); return r; }
template <int ACT> struct EpiBf16 {
    static constexpr bool PERM = true, AFTER_DRAIN = false;
    bf16_t* O; int ldc;
    __device__ __forceinline__ void operator()(const f32x4 (&acc)[2][2][4][2], const Unit& u, int wr, int wc, int fr, int fq) const {
        const int row0 = u.pm * BM + wr * 64 + fr; const int col0 = u.pn * BM + wc * 32 + 8 * fq;
#pragma unroll
        for (int ai = 0; ai < 2; ++ai)
#pragma unroll
            for (int m = 0; m < 4; ++m) { bf16_t* rowp = O + (size_t)(row0 + ai * HALF + m * 16) * ldc + col0;
#pragma unroll
                for (int bj = 0; bj < 2; ++bj) { f32x4 v0 = acc[ai][bj][m][0], v1 = acc[ai][bj][m][1];
                    if (ACT == 2) {
#pragma unroll
                        for (int e = 0; e < 4; ++e) { float a = v0[e] > 0.f ? v0[e] : 0.f; v0[e] = a * a; float b = v1[e] > 0.f ? v1[e] : 0.f; v1[e] = b * b; } }
                    u32x4 w; w.x = cvt_pk_bf16(v0[0], v0[1]); w.y = cvt_pk_bf16(v0[2], v0[3]); w.z = cvt_pk_bf16(v1[0], v1[1]); w.w = cvt_pk_bf16(v1[2], v1[3]);
                    *(u32x4*)(rowp + bj * HALF) = w; } }
    }
};
struct EpiFinal {
    static constexpr bool PERM = true, AFTER_DRAIN = false;
    float* out; const bf16_t* PP; const bf16_t* X2; int ldc;
    __device__ __forceinline__ void operator()(const f32x4 (&acc)[2][2][4][2], const Unit& u, int wr, int wc, int fr, int fq) const {
        const int col0 = u.pn * BM + wc * 32 + 8 * fq;
        u32x4 xs[2][2], pw[2][2];
#define EF_LOAD(gi, buf) do { const int ai_ = (gi) >> 2, m_ = (gi) & 3; const size_t off_ = (size_t)(u.pm * BM + ai_ * HALF + wr * 64 + m_ * 16 + fr) * ldc + col0; \
        _Pragma("unroll") for (int q = 0; q < 2; ++q) { xs[buf][q] = *(const u32x4*)(X2 + off_ + q * HALF); pw[buf][q] = *(const u32x4*)(PP + off_ + q * HALF); } } while (0)
        EF_LOAD(0, 0);
#pragma unroll
        for (int gi = 0; gi < 8; ++gi) {
            if (gi + 1 < 8) EF_LOAD(gi + 1, (gi + 1) & 1);
            asm volatile("" ::: "memory");
            const int ai = gi >> 2, m = gi & 3; const size_t off = (size_t)(u.pm * BM + ai * HALF + wr * 64 + m * 16 + fr) * ldc + col0;
#pragma unroll
            for (int bj = 0; bj < 2; ++bj) { const u32x4 w = pw[gi & 1][bj], xw = xs[gi & 1][bj];
#pragma unroll
                for (int n = 0; n < 2; ++n) { const f32x4 a = acc[ai][bj][m][n]; const unsigned wa = n ? w.z : w.x, wb = n ? w.w : w.y, xa = n ? xw.z : xw.x, xb = n ? xw.w : xw.y;
                    f32x4 p, xf; p[0] = __uint_as_float(wa << 16); p[1] = __uint_as_float(wa & 0xffff0000u); p[2] = __uint_as_float(wb << 16); p[3] = __uint_as_float(wb & 0xffff0000u);
                    xf[0] = __uint_as_float(xa << 16); xf[1] = __uint_as_float(xa & 0xffff0000u); xf[2] = __uint_as_float(xb << 16); xf[3] = __uint_as_float(xb & 0xffff0000u);
                    f32x4 res;
#pragma unroll
                    for (int e = 0; e < 4; ++e) res[e] = xf[e] + p[e] * __builtin_amdgcn_rcpf(1.f + __expf(-a[e]));
                    *(f32x4*)(out + off + bj * HALF + n * 4) = res; } }
        }
#undef EF_LOAD
    }
};
struct RowSumSq {
    float* xbuf;
    unsigned* cnt;
    __device__ __forceinline__ void run(const f32x4 (&v)[2][2][4][2], const Unit& u, int wr, int wc, int fr, int fq, PG8_LAS unsigned char* lds, int wid, int lane) const {
        PG8_LAS float* P = (PG8_LAS float*)lds;
        PG8_LAS float* S = (PG8_LAS float*)(lds + 4096);
#pragma unroll
        for (int ai = 0; ai < 2; ++ai)
#pragma unroll
            for (int m = 0; m < 4; ++m) { float s = 0.f;
#pragma unroll
                for (int bj = 0; bj < 2; ++bj)
#pragma unroll
                    for (int n = 0; n < 2; ++n) { const f32x4 x = v[ai][bj][m][n]; s += (x[0] * x[0] + x[1] * x[1]) + (x[2] * x[2] + x[3] * x[3]); }
                s += __shfl_xor(s, 16); s += __shfl_xor(s, 32);
                if (fq == 0) P[(ai * HALF + wr * 64 + m * 16 + fr) * 4 + wc] = s; }
        asm volatile("s_waitcnt lgkmcnt(0)" ::: "memory"); __builtin_amdgcn_s_barrier(); asm volatile("" ::: "memory");
        const int row = wid * 32 + (lane & 31);
        if (lane < 32) { const float t = (P[row * 4 + 0] + P[row * 4 + 1]) + (P[row * 4 + 2] + P[row * 4 + 3]);
            __hip_atomic_store(xbuf + ((size_t)(u.pm * BM + row) * 4 + u.pn), t, __ATOMIC_RELAXED, __HIP_MEMORY_SCOPE_AGENT); }
        asm volatile("s_waitcnt vmcnt(0)" ::: "memory");
        if (lane == 0) __hip_atomic_fetch_add(cnt + 64 * u.pm, 1u, __ATOMIC_RELAXED, __HIP_MEMORY_SCOPE_AGENT);
        if (wid == 0) { unsigned sp = 0u;
            for (;;) { if ((unsigned)__builtin_amdgcn_readfirstlane(__hip_atomic_load(cnt + 64 * u.pm, __ATOMIC_RELAXED, __HIP_MEMORY_SCOPE_AGENT)) >= 32u) break;
                if (++sp > (1u << 21)) break;
                __builtin_amdgcn_s_sleep(2); }
            __builtin_amdgcn_fence(__ATOMIC_ACQUIRE, "agent"); }
        asm volatile("s_waitcnt vmcnt(0) lgkmcnt(0)" ::: "memory"); __builtin_amdgcn_s_barrier(); asm volatile("" ::: "memory");
        if (lane < 32) { const float* slot = xbuf + (size_t)(u.pm * BM + row) * 4;
            const float t0 = __hip_atomic_load(slot + 0, __ATOMIC_RELAXED, __HIP_MEMORY_SCOPE_AGENT), t1 = __hip_atomic_load(slot + 1, __ATOMIC_RELAXED, __HIP_MEMORY_SCOPE_AGENT);
            const float t2 = __hip_atomic_load(slot + 2, __ATOMIC_RELAXED, __HIP_MEMORY_SCOPE_AGENT), t3 = __hip_atomic_load(slot + 3, __ATOMIC_RELAXED, __HIP_MEMORY_SCOPE_AGENT);
            S[row] = (t0 + t1) + (t2 + t3); }
        asm volatile("s_waitcnt lgkmcnt(0)" ::: "memory"); __builtin_amdgcn_s_barrier(); asm volatile("" ::: "memory");
    }
};
struct EpiMixNorm {
    static constexpr bool PERM = true, AFTER_DRAIN = true;
    const float* gpost; const float* gffn; bf16_t* X1; bf16_t* U; int ldc; float eps; RowSumSq st1, st2;
    __device__ __forceinline__ void fused(f32x4 (&acc)[2][2][4][2], const Unit& u, int wr, int wc, int fr, int fq, PG8_LAS unsigned char* lds, int wid, int lane) const {
        const PG8_LAS float* S = (const PG8_LAS float*)(lds + 4096);
        const int col0 = u.pn * BM + wc * 32 + 8 * fq;
        st1.run(acc, u, wr, wc, fr, fq, lds, wid, lane);
        f32x4 gv[2][2];
#pragma unroll
        for (int bj = 0; bj < 2; ++bj)
#pragma unroll
            for (int n = 0; n < 2; ++n) gv[bj][n] = *(const f32x4*)(gpost + col0 + bj * HALF + n * 4);
#pragma unroll
        for (int ai = 0; ai < 2; ++ai)
#pragma unroll
            for (int m = 0; m < 4; ++m) { const int r = ai * HALF + wr * 64 + m * 16 + fr; const float rs = 1.0f / sqrtf(S[r] * (1.0f / 1024.0f) + eps); const size_t off = (size_t)(u.pm * BM + r) * ldc + col0;
#pragma unroll
                for (int bj = 0; bj < 2; ++bj) { const u32x4 xw = *(const u32x4*)(X1 + off + bj * HALF);
                    f32x4 x0, x1; x0[0] = __uint_as_float(xw.x << 16); x0[1] = __uint_as_float(xw.x & 0xffff0000u); x0[2] = __uint_as_float(xw.y << 16); x0[3] = __uint_as_float(xw.y & 0xffff0000u);
                    x1[0] = __uint_as_float(xw.z << 16); x1[1] = __uint_as_float(xw.z & 0xffff0000u); x1[2] = __uint_as_float(xw.w << 16); x1[3] = __uint_as_float(xw.w & 0xffff0000u);
                    acc[ai][bj][m][0] = x0 + acc[ai][bj][m][0] * gv[bj][0] * rs; acc[ai][bj][m][1] = x1 + acc[ai][bj][m][1] * gv[bj][1] * rs; }
                asm volatile("" : "+v"(acc[ai][0][m][0]), "+v"(acc[ai][0][m][1]), "+v"(acc[ai][1][m][0]), "+v"(acc[ai][1][m][1]));
                if (m & 1) asm volatile("" ::: "memory"); }
        st2.run(acc, u, wr, wc, fr, fq, lds, wid, lane);
#pragma unroll
        for (int bj = 0; bj < 2; ++bj)
#pragma unroll
            for (int n = 0; n < 2; ++n) gv[bj][n] = *(const f32x4*)(gffn + col0 + bj * HALF + n * 4);
#pragma unroll
        for (int ai = 0; ai < 2; ++ai)
#pragma unroll
            for (int m = 0; m < 4; ++m) { const int r = ai * HALF + wr * 64 + m * 16 + fr; const float rs = 1.0f / sqrtf(S[r] * (1.0f / 1024.0f) + eps); const size_t off = (size_t)(u.pm * BM + r) * ldc + col0;
#pragma unroll
                for (int bj = 0; bj < 2; ++bj) { const f32x4 a0 = acc[ai][bj][m][0], a1 = acc[ai][bj][m][1]; const f32x4 o0 = a0 * gv[bj][0] * rs, o1 = a1 * gv[bj][1] * rs; const size_t oo = off + bj * HALF;
                    u32x4 w1; w1.x = cvt_pk_bf16(a0[0], a0[1]); w1.y = cvt_pk_bf16(a0[2], a0[3]); w1.z = cvt_pk_bf16(a1[0], a1[1]); w1.w = cvt_pk_bf16(a1[2], a1[3]); *(u32x4*)(X1 + oo) = w1;
                    u32x4 w2; w2.x = cvt_pk_bf16(o0[0], o0[1]); w2.y = cvt_pk_bf16(o0[2], o0[3]); w2.z = cvt_pk_bf16(o1[0], o1[1]); w2.w = cvt_pk_bf16(o1[2], o1[3]); *(u32x4*)(U + oo) = w2; } }
    }
};
struct EpiFfnNorm {
    static constexpr bool PERM = true, AFTER_DRAIN = true;
    const bf16_t* X1; const float* g; bf16_t* X2; int ldc; float eps; RowSumSq st;
    __device__ __forceinline__ void fused(f32x4 (&acc)[2][2][4][2], const Unit& u, int wr, int wc, int fr, int fq, PG8_LAS unsigned char* lds, int wid, int lane) const {
        const PG8_LAS float* S = (const PG8_LAS float*)(lds + 4096);
        const int col0 = u.pn * BM + wc * 32 + 8 * fq;
        st.run(acc, u, wr, wc, fr, fq, lds, wid, lane);
        f32x4 gv[2][2];
#pragma unroll
        for (int bj = 0; bj < 2; ++bj)
#pragma unroll
            for (int n = 0; n < 2; ++n) gv[bj][n] = *(const f32x4*)(g + col0 + bj * HALF + n * 4);
#pragma unroll
        for (int ai = 0; ai < 2; ++ai)
#pragma unroll
            for (int m = 0; m < 4; ++m) { const int r = ai * HALF + wr * 64 + m * 16 + fr; const float rs = 1.0f / sqrtf(S[r] * (1.0f / 1024.0f) + eps); const size_t off = (size_t)(u.pm * BM + r) * ldc + col0;
#pragma unroll
                for (int bj = 0; bj < 2; ++bj) { const size_t oo = off + bj * HALF; const u32x4 xw = *(const u32x4*)(X1 + oo);
                    f32x4 x0, x1; x0[0] = __uint_as_float(xw.x << 16); x0[1] = __uint_as_float(xw.x & 0xffff0000u); x0[2] = __uint_as_float(xw.y << 16); x0[3] = __uint_as_float(xw.y & 0xffff0000u);
                    x1[0] = __uint_as_float(xw.z << 16); x1[1] = __uint_as_float(xw.z & 0xffff0000u); x1[2] = __uint_as_float(xw.w << 16); x1[3] = __uint_as_float(xw.w & 0xffff0000u);
                    const f32x4 o0 = x0 + acc[ai][bj][m][0] * gv[bj][0] * rs, o1 = x1 + acc[ai][bj][m][1] * gv[bj][1] * rs;
                    u32x4 w; w.x = cvt_pk_bf16(o0[0], o0[1]); w.y = cvt_pk_bf16(o0[2], o0[3]); w.z = cvt_pk_bf16(o1[0], o1[1]); w.w = cvt_pk_bf16(o1[2], o1[3]); *(u32x4*)(X2 + oo) = w; }
                if (m & 1) asm volatile("" ::: "memory"); }
    }
};
template <class Epi, class Sched, bool ALIGN_EPI = false, bool SP2 = false>
__device__ __forceinline__ void gemm_phase(PG8_LAS unsigned char* lds, const Gemm g, const Sched& S, const Epi& E) {
    const int tid = threadIdx.x, wid = __builtin_amdgcn_readfirstlane(tid >> 6), lane = tid & 63, wr = wid >> 2, wc = wid & 3, fr = lane & 15, fq = lane >> 4;
    const int K = g.K, nt = K / BK;
    unsigned voffA[2], voffB[2];
#pragma unroll
    for (int i = 0; i < 2; ++i) { int R, C; stage_rc(tid * 16 + i * 8192, R, C); const int Rb = Epi::PERM ? ((R & ~31) + perm32(R & 31)) : R;
        voffA[i] = (unsigned)(R * K + C) * 2u; voffB[i] = (unsigned)(Rb * K + C) * 2u; }
    const size_t kstep = (size_t)(BK * 2);
    const size_t hstep = (size_t)HALF * K * 2;
    const size_t tstep = 2 * hstep;
    const unsigned ldsw = (unsigned)wid * 1024u;
    const int aoff = lds_byte(wr * 64 + fr, fq * 8), boff = lds_byte(wc * 32 + fr, fq * 8);
#define PG8_SA(b, h) (((b) * 2 + (h)) * HTB)
#define PG8_SB(b, h) ((4 + (b) * 2 + (h)) * HTB)
#define PG8_STAGE(bufoff, gbase, voff) do { _Pragma("unroll") for (int _i = 0; _i < 2; ++_i) \
        __builtin_amdgcn_global_load_lds((const unsigned*)((const char*)(gbase) + (voff)[_i]), (PG8_LAS unsigned*)(lds + (bufoff) + ldsw + _i * 8192), 16, 0, 0); } while (0)
#define PG8_LDA(dst, b, h) do { _Pragma("unroll") for (int m = 0; m < 4; ++m) _Pragma("unroll") for (int k = 0; k < 2; ++k) dst[m][k] = *(const PG8_LAS bf16x8*)(lds + PG8_SA(b, h) + aoff + m * 2048 + k * 1024); } while (0)
#define PG8_LDB(dst, b, h) do { _Pragma("unroll") for (int n = 0; n < 2; ++n) _Pragma("unroll") for (int k = 0; k < 2; ++k) dst[n][k] = *(const PG8_LAS bf16x8*)(lds + PG8_SB(b, h) + boff + n * 2048 + k * 1024); } while (0)
#define PG8_MMA(ai, bj, At, Bt) do { __builtin_amdgcn_s_setprio(1); _Pragma("unroll") for (int m = 0; m < 4; ++m) _Pragma("unroll") for (int n = 0; n < 2; ++n) _Pragma("unroll") for (int k = 0; k < 2; ++k) \
        acc[ai][bj][m][n] = __builtin_amdgcn_mfma_f32_16x16x32_bf16(Bt[n][k], At[m][k], acc[ai][bj][m][n], 0, 0, 0); __builtin_amdgcn_s_setprio(0); } while (0)
#define PG8_WAIT_V(n) asm volatile("s_waitcnt vmcnt(" #n ")" ::: "memory")
#define PG8_WAIT_L(n) asm volatile("s_waitcnt lgkmcnt(" #n ")" ::: "memory")
#define PG8_BAR __builtin_amdgcn_s_barrier()
#define PG8_SCHED __builtin_amdgcn_sched_barrier(0)
    Unit cur, nxt; int ui = 0;
    if (!S.next(0, cur)) return;
    f32x4 acc[2][2][4][2];
#pragma unroll
    for (int a = 0; a < 2; ++a)
#pragma unroll
        for (int b = 0; b < 2; ++b)
#pragma unroll
            for (int m = 0; m < 4; ++m)
#pragma unroll
                for (int n = 0; n < 2; ++n) acc[a][b][m][n] = (f32x4){0.f, 0.f, 0.f, 0.f};
    bf16x8 At[4][2], B0[2][2], B1[2][2];
    const char* cA = (const char*)g.A + (size_t)cur.pm * tstep; const char* cB = (const char*)g.Bt + (size_t)cur.pn * tstep;
    S.a_ready(cur);
    if constexpr (SP2) {
        PG8_STAGE(PG8_SB(0, 0), cB, voffB); PG8_STAGE(PG8_SB(0, 1), cB + hstep, voffB); PG8_STAGE(PG8_SA(0, 0), cA, voffA); PG8_STAGE(PG8_SA(0, 1), cA + hstep, voffA);
        if (wr == 1) PG8_BAR;
        PG8_WAIT_V(2); PG8_BAR;
        PG8_STAGE(PG8_SB(1, 0), cB + kstep, voffB); PG8_STAGE(PG8_SA(1, 0), cA + kstep, voffA); PG8_STAGE(PG8_SB(1, 1), cB + hstep + kstep, voffB);
        PG8_WAIT_V(6); PG8_BAR;
    } else {
        PG8_STAGE(PG8_SB(0, 0), cB, voffB); PG8_STAGE(PG8_SA(0, 0), cA, voffA); PG8_STAGE(PG8_SB(0, 1), cB + hstep, voffB); PG8_STAGE(PG8_SA(0, 1), cA + hstep, voffA);
        if (wr == 1) PG8_BAR;
        PG8_WAIT_V(4); PG8_BAR;
        PG8_STAGE(PG8_SB(1, 0), cB + kstep, voffB); PG8_STAGE(PG8_SA(1, 0), cA + kstep, voffA); PG8_STAGE(PG8_SB(1, 1), cB + hstep + kstep, voffB);
        PG8_WAIT_V(6); PG8_BAR;
    }
    for (;;) {
        const bool has_next = S.next(ui + 1, nxt);
        const char* nA = has_next ? (const char*)g.A + (size_t)nxt.pm * tstep : cA; const char* nB = has_next ? (const char*)g.Bt + (size_t)nxt.pn * tstep : cB;
        for (int t = 0; t < nt; t += 2) {
            const bool last = (t == nt - 2);
            const char* a1 = cA + (size_t)(t + 1) * kstep;
            const char* a2 = last ? nA : cA + (size_t)(t + 2) * kstep; const char* b2 = last ? nB : cB + (size_t)(t + 2) * kstep;
            const char* a3 = a2 + kstep; const char* b3 = b2 + kstep;
            if (last && has_next) S.a_ready(nxt);
            if constexpr (SP2) {
            PG8_LDB(B0, 0, 0); PG8_LDB(B1, 0, 1); PG8_SCHED; PG8_LDA(At, 0, 0); PG8_STAGE(PG8_SA(1, 1), a1 + hstep, voffA);
            PG8_WAIT_V(8); PG8_WAIT_L(0); PG8_BAR; PG8_MMA(0, 0, At, B0); PG8_MMA(0, 1, At, B1); PG8_BAR; PG8_SCHED;
            PG8_LDA(At, 0, 1); PG8_STAGE(PG8_SB(0, 0), b2, voffB); PG8_STAGE(PG8_SB(0, 1), b2 + hstep, voffB); PG8_STAGE(PG8_SA(0, 0), a2, voffA);
            PG8_WAIT_V(8); PG8_WAIT_L(0); PG8_BAR; PG8_MMA(1, 0, At, B0); PG8_MMA(1, 1, At, B1); PG8_BAR; PG8_SCHED;
            PG8_LDB(B0, 1, 0); PG8_LDB(B1, 1, 1); PG8_SCHED; PG8_LDA(At, 1, 0); PG8_STAGE(PG8_SA(0, 1), a2 + hstep, voffA);
            PG8_WAIT_V(8); PG8_WAIT_L(0); PG8_BAR; PG8_MMA(0, 0, At, B0); PG8_MMA(0, 1, At, B1); PG8_BAR; PG8_SCHED;
            PG8_LDA(At, 1, 1); PG8_STAGE(PG8_SB(1, 0), b3, voffB); PG8_STAGE(PG8_SB(1, 1), b3 + hstep, voffB); PG8_STAGE(PG8_SA(1, 0), a3, voffA);
            PG8_WAIT_V(8); PG8_WAIT_L(0); PG8_BAR; PG8_MMA(1, 0, At, B0); PG8_MMA(1, 1, At, B1); PG8_BAR; PG8_SCHED;
            } else {
            PG8_LDB(B0, 0, 0); PG8_SCHED; PG8_LDA(At, 0, 0); PG8_STAGE(PG8_SA(1, 1), a1 + hstep, voffA);
            PG8_WAIT_L(8); PG8_BAR; PG8_WAIT_L(0); PG8_MMA(0, 0, At, B0); PG8_BAR; PG8_SCHED;
            PG8_LDB(B1, 0, 1); PG8_STAGE(PG8_SB(0, 0), b2, voffB);
            PG8_BAR; PG8_WAIT_L(0); PG8_MMA(0, 1, At, B1); PG8_BAR;
            PG8_LDA(At, 0, 1); PG8_STAGE(PG8_SA(0, 0), a2, voffA);
            PG8_BAR; PG8_WAIT_L(0); PG8_MMA(1, 0, At, B0); PG8_BAR; PG8_SCHED;
            PG8_STAGE(PG8_SB(0, 1), b2 + hstep, voffB);
            PG8_WAIT_V(6); PG8_BAR; PG8_MMA(1, 1, At, B1); PG8_BAR;
            PG8_LDB(B0, 1, 0); PG8_SCHED; PG8_LDA(At, 1, 0); PG8_STAGE(PG8_SA(0, 1), a2 + hstep, voffA);
            PG8_WAIT_L(8); PG8_BAR; PG8_WAIT_L(0); PG8_MMA(0, 0, At, B0); PG8_BAR; PG8_SCHED;
            PG8_LDB(B1, 1, 1); PG8_STAGE(PG8_SB(1, 0), b3, voffB);
            PG8_BAR; PG8_WAIT_L(0); PG8_MMA(0, 1, At, B1); PG8_BAR;
            PG8_LDA(At, 1, 1); PG8_STAGE(PG8_SA(1, 0), a3, voffA);
            PG8_BAR; PG8_WAIT_L(0); PG8_MMA(1, 0, At, B0); PG8_BAR; PG8_SCHED;
            PG8_STAGE(PG8_SB(1, 1), b3 + hstep, voffB);
            PG8_WAIT_V(6); PG8_BAR; PG8_MMA(1, 1, At, B1); PG8_BAR;
            }
        }
        if constexpr (ALIGN_EPI) { if (wr == 0) PG8_BAR; }
        if constexpr (!Epi::AFTER_DRAIN) { E(acc, cur, wr, wc, fr, fq); S.done(cur); }
        if (!has_next) break;
#pragma unroll
        for (int a = 0; a < 2; ++a)
#pragma unroll
            for (int b = 0; b < 2; ++b)
#pragma unroll
                for (int m = 0; m < 4; ++m)
#pragma unroll
                    for (int n = 0; n < 2; ++n) acc[a][b][m][n] = (f32x4){0.f, 0.f, 0.f, 0.f};
        cur = nxt; cA = nA; cB = nB; ++ui;
        if constexpr (ALIGN_EPI) { if (wr == 1) PG8_BAR; }
    }
    PG8_WAIT_V(0);
    if constexpr (!ALIGN_EPI) { if (wr == 0) PG8_BAR; }
    PG8_BAR;
    if constexpr (Epi::AFTER_DRAIN) { E.fused(acc, cur, wr, wc, fr, fq, lds, wid, lane); S.done(cur); }
#undef PG8_SA
#undef PG8_SB
#undef PG8_STAGE
#undef PG8_LDA
#undef PG8_LDB
#undef PG8_MMA
#undef PG8_WAIT_V
#undef PG8_WAIT_L
#undef PG8_BAR
#undef PG8_SCHED
}
}
#define LAS __attribute__((address_space(3)))
typedef unsigned short bf16;
typedef float f32x4 __attribute__((ext_vector_type(4)));
typedef float f32x16 __attribute__((ext_vector_type(16)));
typedef short bf16x8 __attribute__((ext_vector_type(8)));
typedef short s16x4 __attribute__((ext_vector_type(4)));
typedef unsigned u32x4 __attribute__((ext_vector_type(4)));
typedef unsigned u32x2 __attribute__((ext_vector_type(2)));
#define LDS_WAIT() asm volatile("s_waitcnt lgkmcnt(0)" ::: "memory")

constexpr int MP = 16384, MS = 512, MT = MP + MS, DM = 1024, NZ = 2304, FF = 4096, PD = 256, SEQ = 8192, PROJ_W = 2312;
constexpr int ZQK = 0, ZV = 512, ZO = 1024, ZQA = 1536, ZKA = 2048, ZVA = 2176;
constexpr float EPS = 1e-6f;
constexpr int NWAVES = 8, NTHR = 512;
constexpr int LDS_BYTES = 147456;
constexpr size_t MiB = 1u << 20;
constexpr size_t WS_WIN = 0, WS_WOUT = 5 * MiB, WS_WUP = 7 * MiB, WS_WDN = 15 * MiB, WS_WPG = 23 * MiB, WS_WPP = 25 * MiB;
constexpr size_t WS_ACTA = 26 * MiB;
constexpr size_t WS_PP = 59 * MiB;
constexpr size_t WS_H = 92 * MiB;
constexpr size_t WS_Z = 92 * MiB;
constexpr size_t WS_MIX = 92 * MiB;
constexpr size_t WS_QC = 167 * MiB;
constexpr size_t WS_CLOC = 184 * MiB;
constexpr size_t WS_CPREV = 200 * MiB;
constexpr size_t WS_PBF = 208 * MiB;
constexpr size_t WS_GATES = 217 * MiB;
constexpr size_t WS_STATS = 218 * MiB;
constexpr size_t WS_D1P = 224 * MiB, WS_D1S = 0;
constexpr size_t WS_CTL = 25 * MiB + 512 * 1024, CTL_BYTES = 81920;
constexpr size_t WS_ATTS = 219 * MiB;
constexpr size_t WS_X2 = WS_ACTA;
constexpr size_t WS_MIXS = 3 * MiB;
constexpr size_t WS_XBUF = 2 * MiB;
constexpr int MISC_OFF = 131072 + 320;
constexpr size_t WS_END = 256 * MiB;
constexpr size_t O_Y = 0, O_CP = 17301504, O_NP = 17367040, O_MP = 17367552, O_CONVP = 17367560, O_KP = 17370632, O_VP = 17403400,
                 O_CS = 17436168, O_NS = 21630472, O_MS = 21663240, O_CONVS = 21663752, O_KS = 21860360, O_VS = 23957512, O_END = 26054664;

__device__ __forceinline__ float bf2f(unsigned short v) { return __uint_as_float(((unsigned)v) << 16); }
__device__ __forceinline__ float bflo(unsigned w) { return __uint_as_float(w << 16); }
__device__ __forceinline__ float bfhi(unsigned w) { return __uint_as_float(w & 0xffff0000u); }
__device__ __forceinline__ unsigned pk2(float lo, float hi) { return pg8::cvt_pk_bf16(lo, hi); }
__device__ __forceinline__ float wave_sum(float v) {
#pragma unroll
    for (int o = 1; o < 64; o <<= 1) v += __shfl_xor(v, o);
    return v;
}
__device__ __forceinline__ float wave_max(float v) {
#pragma unroll
    for (int o = 1; o < 64; o <<= 1) v = fmaxf(v, __shfl_xor(v, o));
    return v;
}
__device__ __forceinline__ float wave_incl_sum(float v, int lane) {
#pragma unroll
    for (int o = 1; o < 64; o <<= 1) { const float n = __shfl_up(v, o); if (lane >= o) v += n; }
    return v;
}
__device__ __forceinline__ float wave_incl_max(float v, int lane) {
#pragma unroll
    for (int o = 1; o < 64; o <<= 1) { const float n = __shfl_up(v, o); if (lane >= o) v = fmaxf(v, n); }
    return v;
}
__device__ __forceinline__ float sigmoidf_(float x) { return 1.f / (1.f + __expf(-x)); }
__device__ __forceinline__ int crow(int r, int hi) { return (r & 3) + 8 * (r >> 2) + 4 * hi; }

struct Args { const float* in[25]; float* out; unsigned char* ws; int ph_lo, ph_hi, coop, pad; };

__device__ __forceinline__ void transpose_item(const float* W, int ldw, int col0, int k0, bf16* WT, int K, int row0, LAS float* scr, int lane) {
    float tv[32];
#pragma unroll
    for (int i = 0; i < 32; ++i) { const int kk = 2 * i + (lane >> 5); tv[i] = W[(size_t)(k0 + kk) * ldw + col0 + (lane & 31)]; }
#pragma unroll
    for (int i = 0; i < 32; ++i) { const int kk = 2 * i + (lane >> 5); scr[kk * 33 + (lane & 31)] = tv[i]; }
    LDS_WAIT(); asm volatile("" ::: "memory");
    const int c = lane & 7;
#pragma unroll
    for (int j = 0; j < 4; ++j) { const int n = (lane >> 3) + 8 * j; const LAS float* s = scr + (8 * c) * 33 + n;
        u32x4 o; o.x = pk2(s[0 * 33], s[1 * 33]); o.y = pk2(s[2 * 33], s[3 * 33]); o.z = pk2(s[4 * 33], s[5 * 33]); o.w = pk2(s[6 * 33], s[7 * 33]);
        *(u32x4*)(WT + (size_t)(row0 + n) * K + k0 + 8 * c) = o; }
    LDS_WAIT(); asm volatile("" ::: "memory");
}

constexpr int I_IN = 16 * 72, I_PP = 4 * 32, I_OUT = 16 * 32, I_UP = 16 * 128, I_DN = 64 * 32, I_PG = 16 * 32;
constexpr int IT_EARLY = I_IN + I_PP, IT_ALL = I_IN + I_PP + I_OUT + I_UP + I_DN + I_PG;
__device__ __forceinline__ void transpose_items(const Args& a, LAS unsigned char* lds, int lo, int hi, int gw, int NGW, int lane, int wave) {
    unsigned char* ws = a.ws;
    LAS float* scr = (LAS float*)(lds + wave * 16384);
    for (int it = lo + gw; it < hi; it += NGW) {
        int r = it;
        if (r < I_IN) { const int kb = r / 72, nb = r % 72; transpose_item(a.in[11], PROJ_W, 32 * nb + (nb >= 48 ? 8 : 0), 64 * kb, (bf16*)(ws + WS_WIN), 1024, 32 * nb, scr, lane); continue; } r -= I_IN;
        if (r < I_PP) { const int kb = r / 32, nb = r % 32; transpose_item(a.in[24], 1024, 32 * nb, 64 * kb, (bf16*)(ws + WS_WPP), 256, 32 * nb, scr, lane); continue; } r -= I_PP;
        if (r < I_OUT) { const int kb = r / 32, nb = r % 32; transpose_item(a.in[17], 1024, 32 * nb, 64 * kb, (bf16*)(ws + WS_WOUT), 1024, 32 * nb, scr, lane); continue; } r -= I_OUT;
        if (r < I_UP) { const int kb = r / 128, nb = r % 128; transpose_item(a.in[20], 4096, 32 * nb, 64 * kb, (bf16*)(ws + WS_WUP), 1024, 32 * nb, scr, lane); continue; } r -= I_UP;
        if (r < I_DN) { const int kb = r / 32, nb = r % 32; transpose_item(a.in[21], 1024, 32 * nb, 64 * kb, (bf16*)(ws + WS_WDN), 4096, 32 * nb, scr, lane); continue; } r -= I_DN;
        { const int kb = r / 32, nb = r % 32; transpose_item(a.in[23], 1024, 32 * nb, 64 * kb, (bf16*)(ws + WS_WPG), 1024, 32 * nb, scr, lane); }
    }
}
__device__ __forceinline__ void p0_prologue(const Args& a, LAS unsigned char* lds, int tid, int lane, int wave) {
    unsigned char* ws = a.ws;
    const int gw = blockIdx.x * NWAVES + wave, NGW = gridDim.x * NWAVES;
    transpose_items(a, lds, 0, IT_EARLY, gw, NGW, lane, wave);
    __syncthreads();
    LAS float* wg = (LAS float*)lds;
    for (int i = tid; i < 8192; i += NTHR) wg[i] = a.in[11][(size_t)(i >> 3) * PROJ_W + 1536 + (i & 7)];
    __syncthreads();
    const float* gpre = a.in[10];
    bf16* XN = (bf16*)(ws + WS_ACTA); bf16* PBF = (bf16*)(ws + WS_PBF); float* GATES = (float*)(ws + WS_GATES);
    f32x4 gq[4];
#pragma unroll
    for (int j = 0; j < 4; ++j) gq[j] = *(const f32x4*)(gpre + 4 * lane + 256 * j);
    f32x4 nv[4], npv;
    { const int m = gw < MT ? gw : 0; const float* xr = m < MP ? a.in[0] + (size_t)m * DM : a.in[1] + (size_t)(m - MP) * DM; const float* pr = m < MP ? a.in[2] + (size_t)m * PD : a.in[3] + (size_t)(m - MP) * PD;
#pragma unroll
      for (int j = 0; j < 4; ++j) nv[j] = *(const f32x4*)(xr + 4 * lane + 256 * j);
      npv = *(const f32x4*)(pr + 4 * lane); }
    for (int m = gw; m < MT; m += NGW) {
        f32x4 v[4]; float s = 0.f;
#pragma unroll
        for (int j = 0; j < 4; ++j) { v[j] = nv[j]; s += (v[j][0] * v[j][0] + v[j][1] * v[j][1]) + (v[j][2] * v[j][2] + v[j][3] * v[j][3]); }
        const f32x4 pv = npv;
        { const int m2 = (m + NGW < MT) ? m + NGW : m; const float* xr = m2 < MP ? a.in[0] + (size_t)m2 * DM : a.in[1] + (size_t)(m2 - MP) * DM; const float* pr = m2 < MP ? a.in[2] + (size_t)m2 * PD : a.in[3] + (size_t)(m2 - MP) * PD;
#pragma unroll
          for (int j = 0; j < 4; ++j) nv[j] = *(const f32x4*)(xr + 4 * lane + 256 * j);
          npv = *(const f32x4*)(pr + 4 * lane); }
        const float rs = 1.f / sqrtf(wave_sum(s) * (1.f / DM) + EPS);
        if (m < MP) {
#pragma unroll
            for (int j = 0; j < 4; ++j) { u32x2 o; o.x = pk2(v[j][0], v[j][1]); o.y = pk2(v[j][2], v[j][3]); *(u32x2*)((bf16*)(ws + WS_D1P) + (size_t)m * DM + 4 * lane + 256 * j) = o; } }
        float ga[8];
#pragma unroll
        for (int q = 0; q < 8; ++q) ga[q] = 0.f;
#pragma unroll
        for (int j = 0; j < 4; ++j) { const f32x4 g = gq[j];
#pragma unroll
            for (int e = 0; e < 4; ++e) { v[j][e] = v[j][e] * rs * g[e]; const LAS f32x4* wp = (const LAS f32x4*)(wg + (4 * lane + 256 * j + e) * 8); const f32x4 w0 = wp[0], w1 = wp[1];
                ga[0] += v[j][e] * w0[0]; ga[1] += v[j][e] * w0[1]; ga[2] += v[j][e] * w0[2]; ga[3] += v[j][e] * w0[3];
                ga[4] += v[j][e] * w1[0]; ga[5] += v[j][e] * w1[1]; ga[6] += v[j][e] * w1[2]; ga[7] += v[j][e] * w1[3]; }
            u32x2 o; o.x = pk2(v[j][0], v[j][1]); o.y = pk2(v[j][2], v[j][3]);
            *(u32x2*)(XN + (size_t)m * DM + 4 * lane + 256 * j) = o; }
        {
            const bool b0 = lane & 1, b1 = lane & 2, b2 = lane & 4;
            float k4[4], k2[2];
#pragma unroll
            for (int q = 0; q < 4; ++q) { const float send = b0 ? ga[q] : ga[q + 4]; const float recv = __shfl_xor(send, 1); k4[q] = (b0 ? ga[q + 4] : ga[q]) + recv; }
#pragma unroll
            for (int q = 0; q < 2; ++q) { const float send = b1 ? k4[q] : k4[q + 2]; const float recv = __shfl_xor(send, 2); k2[q] = (b1 ? k4[q + 2] : k4[q]) + recv; }
            const float send = b2 ? k2[0] : k2[1]; float t = (b2 ? k2[1] : k2[0]) + __shfl_xor(send, 4);
            t += __shfl_xor(t, 8); t += __shfl_xor(t, 16); t += __shfl_xor(t, 32);
            if (lane < 8) GATES[(size_t)m * 8 + 4 * (lane & 1) + (lane & 2) + ((lane >> 2) & 1)] = t; }
        { u32x2 o; o.x = pk2(pv[0], pv[1]); o.y = pk2(pv[2], pv[3]); *(u32x2*)(PBF + (size_t)m * PD + 4 * lane) = o; }
    }
}

__device__ __forceinline__ void chunk_scalars(const float* GATES, const float* bg, int row0, int h, LAS float* SA, LAS float* SB, LAS float* TMP, int tid, int lane, int wave, float& a_out, float& b_out) {
    float s = 0.f, gi = 0.f;
    if (tid < 128) { const float* gp = GATES + (size_t)(row0 + tid) * 8; gi = gp[h] + bg[h]; const float gf = gp[4 + h] + bg[4 + h];
        const float lf = fminf(gf, 0.f) - log1pf(expf(-fabsf(gf))); s = wave_incl_sum(lf, lane); if (lane == 63) TMP[wave] = s; }
    __syncthreads();
    if (tid < 128) { if (wave == 1) s += TMP[0]; SB[tid] = s; SA[tid] = gi - s; }
    a_out = gi - s; b_out = s;
    __syncthreads();
}
template <int NT>
__device__ __forceinline__ void load_vt(const bf16* Z, int row0, int colbase, LAS unsigned* VT32, int t) {
#pragma unroll
    for (int i = 0; i < 1024 / NT; ++i) { const int item = t + NT * i, ch = item & 15, tp = item >> 4;
        const bf16* p0 = Z + (size_t)(row0 + 2 * tp) * NZ + colbase + ch * 8;
        const u32x4 a0 = *(const u32x4*)p0, b0 = *(const u32x4*)(p0 + NZ);
        LAS unsigned* d = VT32 + (ch * 8) * 68 + (((tp >> 2) ^ ch) * 4 + (tp & 3));
#pragma unroll
        for (int e = 0; e < 4; ++e) { d[(2 * e) * 68] = (a0[e] & 0xffffu) | (b0[e] << 16); d[(2 * e + 1) * 68] = (a0[e] >> 16) | (b0[e] & 0xffff0000u); } }
}
__device__ __forceinline__ int vt_off(int row, int oct) { return row * 136 + ((oct ^ ((row >> 3) & 15)) << 3); }

__device__ __forceinline__ void mlstm_b1_unit(const Args& a, LAS unsigned char* lds, int unit, int tid, int lane, int wave) {
    unsigned char* ws = a.ws;
    const bf16* Z = (const bf16*)(ws + WS_Z); bf16* QC = (bf16*)(ws + WS_QC); const float* GATES = (const float*)(ws + WS_GATES);
    float* CLOC = (float*)(ws + WS_CLOC); float* STATS = (float*)(ws + WS_STATS);
    const int bh = unit >> 6, c = unit & 63, b = bh >> 2, h = bh & 3, row0 = b * SEQ + c * 128;
    LAS unsigned* VT32 = (LAS unsigned*)lds; LAS unsigned* KT32 = (LAS unsigned*)(lds + 34816);
    LAS float* SA = (LAS float*)(lds + 52224); LAS float* SB = SA + 128; LAS float* SW = SA + 256; LAS float* TMP = SA + 384;
    float av, bv;
    chunk_scalars(GATES, a.in[12], row0, h, SA, SB, TMP, tid, lane, wave, av, bv);
    if (tid < 128) { const float wm = wave_max(av); if (lane == 0) TMP[4 + wave] = wm; }
    __syncthreads();
    const float amax = fmaxf(TMP[4], TMP[5]), blast = SB[127];
    if (tid < 128) SW[tid] = expf(av - amax);
    if (tid == 0) { STATS[65536 + unit] = blast + amax; STATS[65536 + 512 + unit] = blast; }
    __syncthreads();
    load_vt<NTHR>(Z, row0, ZV + h * 128, VT32, tid);
    {
        const float* cw = a.in[13];
#pragma unroll
        for (int it = 0; it < 2; ++it) {
            const int item = tid + NTHR * it, ch = item & 15, tp = item >> 4; const bool isk = ch >= 8;
            const int cc = (isk ? 256 : 0) + h * 64 + (ch & 7) * 8;
            const int t0 = 2 * tp; const float w0s = SW[t0], w1s = SW[t0 + 1];
            float r[5][8];
#pragma unroll
            for (int j = 0; j < 5; ++j) { const int tt = c * 128 + t0 - 3 + j;
                if (tt >= 0) { const u32x4 w = *(const u32x4*)(Z + (size_t)(row0 + t0 - 3 + j) * NZ + cc);
#pragma unroll
                    for (int e = 0; e < 4; ++e) { r[j][2 * e] = bflo(w[e]); r[j][2 * e + 1] = bfhi(w[e]); } }
                else {
#pragma unroll
                    for (int e = 0; e < 8; ++e) r[j][e] = 0.f; } }
            float o0[8], o1[8];
#pragma unroll
            for (int e = 0; e < 8; ++e) { const float c0 = cw[cc + e], c1 = cw[512 + cc + e], c2 = cw[1024 + cc + e], c3 = cw[1536 + cc + e];
                float x0 = c0 * r[0][e] + c1 * r[1][e] + c2 * r[2][e] + c3 * r[3][e]; float x1 = c0 * r[1][e] + c1 * r[2][e] + c2 * r[3][e] + c3 * r[4][e];
                x0 = x0 * sigmoidf_(x0); x1 = x1 * sigmoidf_(x1);
                if (!isk) { x0 *= 0.125f; x1 *= 0.125f; }
                o0[e] = x0; o1[e] = x1; }
            u32x4 s0, s1;
#pragma unroll
            for (int e = 0; e < 4; ++e) { s0[e] = pk2(o0[2 * e], o0[2 * e + 1]); s1[e] = pk2(o1[2 * e], o1[2 * e + 1]); }
            *(u32x4*)(QC + (size_t)(row0 + t0) * 512 + cc) = s0; *(u32x4*)(QC + (size_t)(row0 + t0 + 1) * 512 + cc) = s1;
            if (isk) { const int g = ch & 7; LAS unsigned* d = KT32 + (g * 8) * 68 + (((tp >> 2) ^ g) * 4 + (tp & 3));
#pragma unroll
                for (int e = 0; e < 8; ++e) d[e * 68] = pk2(o0[e] * w0s, o1[e] * w1s); }
        }
    }
    __syncthreads();
    {
        const int vt = wave >> 1, dt = wave & 1, l32 = lane & 31, hi = lane >> 5;
        const LAS bf16* VT = (const LAS bf16*)VT32; const LAS bf16* KT = (const LAS bf16*)KT32;
        f32x16 acc = {};
#pragma unroll
        for (int s0 = 0; s0 < 128; s0 += 16) {
            const int oct = (s0 >> 3) + hi, rv = vt * 32 + l32, rk = dt * 32 + l32;
            const bf16x8 A = *(const LAS bf16x8*)(VT + vt_off(rv, oct));
            const bf16x8 B = *(const LAS bf16x8*)(KT + rk * 136 + ((oct ^ ((rk >> 3) & 7)) << 3));
            acc = __builtin_amdgcn_mfma_f32_32x32x16_bf16(A, B, acc, 0, 0, 0); }
        float* cp = CLOC + (size_t)unit * 8192 + dt * 32 + l32;
#pragma unroll
        for (int r = 0; r < 16; ++r) cp[(vt * 32 + crow(r, hi)) * 64] = acc[r];
        if (tid < 64) { float s = 0.f;
#pragma unroll
            for (int q = 0; q < 16; ++q) { const u32x4 w = *(const LAS u32x4*)(KT + tid * 136 + 8 * q);
#pragma unroll
                for (int e = 0; e < 4; ++e) s += bflo(w[e]) + bfhi(w[e]); }
            STATS[unit * 64 + tid] = s; }
    }
    __syncthreads();
}

__device__ __forceinline__ void mlstm_scan(const Args& a, int tid) {
    unsigned char* ws = a.ws;
    const float* CLOC = (const float*)(ws + WS_CLOC); bf16* CPREV = (bf16*)(ws + WS_CPREV); float* STATS = (float*)(ws + WS_STATS);
    const float* NLOC = STATS; float* NPREV = STATS + 32768; const float* MLOC = STATS + 65536; const float* BLAST = STATS + 65536 + 512; float* MPREV = STATS + 65536 + 1024;
    const int j = blockIdx.x;
    if (j < 128) {
        const int e = j * 512 + tid, bh = e >> 13, idx = e & 8191;
        float C = 0.f, m = 0.f;
        {
            constexpr int c0 = 0;
            float cl[64];
#pragma unroll
            for (int i = 0; i < 64; ++i) cl[i] = CLOC[(size_t)(bh * 64 + i) * 8192 + idx];
#pragma unroll
            for (int i = 0; i < 64; ++i) { const int u = bh * 64 + c0 + i; const float bl = BLAST[u], ml = MLOC[u];
                CPREV[(size_t)u * 8192 + idx] = (bf16)(pk2(C, 0.f) & 0xffffu);
                const float mn = fmaxf(bl + m, ml); C = expf(bl + m - mn) * C + expf(ml - mn) * cl[i]; m = mn; }
        }
        const int v = idx >> 6, d = idx & 63;
        a.out[O_CP + (size_t)bh * 8192 + d * 128 + v] = C;
    } else if (j == 128) {
        const int bh = tid >> 6, d = tid & 63;
        float n = 0.f, m = 0.f;
        for (int c0 = 0; c0 < 64; c0 += 16) {
            float nl[16], bl[16], ml[16];
#pragma unroll
            for (int i = 0; i < 16; ++i) { const int u = bh * 64 + c0 + i; nl[i] = NLOC[u * 64 + d]; bl[i] = BLAST[u]; ml[i] = MLOC[u]; }
#pragma unroll
            for (int i = 0; i < 16; ++i) { const int u = bh * 64 + c0 + i;
                NPREV[u * 64 + d] = n; if (d == 0) MPREV[u] = m;
                const float mn = fmaxf(bl[i] + m, ml[i]); n = expf(bl[i] + m - mn) * n + expf(ml[i] - mn) * nl[i]; m = mn; } }
        a.out[O_NP + bh * 64 + d] = n; if (d == 0) a.out[O_MP + bh] = m;
    }
}

__device__ __forceinline__ void mlstm_b3_pair(const Args& a, LAS unsigned char* lds0, int u0, int tid, int lane, int wave) {
    unsigned char* ws = a.ws;
    const bf16* Z = (const bf16*)(ws + WS_Z); const bf16* QC = (const bf16*)(ws + WS_QC); const float* GATES = (const float*)(ws + WS_GATES);
    const bf16* CPREV = (const bf16*)(ws + WS_CPREV); const float* STATS = (const float*)(ws + WS_STATS); bf16* YMIX = (bf16*)(ws + WS_ACTA);
    const int half = wave >> 2, lw = wave & 3, lt = tid & 255, unit = u0 + half;
    LAS unsigned char* lds = lds0 + half * 57344;
    const int bh = unit >> 6, c = unit & 63, b = bh >> 2, h = bh & 3, row0 = b * SEQ + c * 128;
    LAS unsigned* VT32 = (LAS unsigned*)lds; LAS bf16* KL = (LAS bf16*)(lds + 34816);
    LAS float* SA = (LAS float*)(lds + 53248); LAS float* SB = SA + 128; LAS float* SM = SA + 256; LAS float* TMP = SA + 384; LAS float* NP = SA + 400; LAS float* GM = SA + 464;
    const int tb = lw, l32 = lane & 31, hi = lane >> 5, t = tb * 32 + l32;
    const size_t rowt = (size_t)(row0 + t);
    bf16x8 qf[4];
#pragma unroll
    for (int d0 = 0; d0 < 4; ++d0) qf[d0] = *(const bf16x8*)(QC + rowt * 512 + h * 64 + d0 * 16 + 8 * hi);
    bf16x8 cf[4][4];
#pragma unroll
    for (int vt = 0; vt < 4; ++vt)
#pragma unroll
        for (int d0 = 0; d0 < 4; ++d0) cf[vt][d0] = *(const bf16x8*)(CPREV + ((size_t)unit * 128 + vt * 32 + l32) * 64 + d0 * 16 + 8 * hi);
    {
#pragma unroll
      for (int i = 0; i < 4; ++i) { const int idx = lt + 256 * i, s = idx >> 3, ch = idx & 7;
          *(LAS u32x4*)(KL + s * 72 + ch * 8) = *(const u32x4*)(QC + (size_t)(row0 + s) * 512 + 256 + h * 64 + ch * 8); } }
    const float mprev = STATS[65536 + 1024 + unit];
    float s = 0.f, gi = 0.f, pm = 0.f;
    if (lt < 128) { const float* gp = GATES + (size_t)(row0 + lt) * 8; gi = gp[h] + a.in[12][h]; const float gf = gp[4 + h] + a.in[12][4 + h];
        const float lf = fminf(gf, 0.f) - log1pf(expf(-fabsf(gf))); s = wave_incl_sum(lf, lane); if (lane == 63) TMP[lw] = s; }
    if (lt >= 128 && lt < 192) NP[lt - 128] = STATS[32768 + unit * 64 + (lt - 128)];
    if (lt >= 192) { GM[lt - 192] = a.in[14][h * 128 + lt - 192]; GM[lt - 128] = a.in[14][h * 128 + lt - 128]; }
    load_vt<256>(Z, row0, ZV + h * 128, VT32, lt);
    __syncthreads();
    float av = 0.f;
    if (lt < 128) { if (lw == 1) s += TMP[0]; SB[lt] = s; av = gi - s; SA[lt] = av; pm = wave_incl_max(av, lane); if (lane == 63) TMP[4 + lw] = pm; }
    __syncthreads();
    if (lt < 128) { if (lw == 1) pm = fmaxf(pm, TMP[4]); SM[lt] = fmaxf(mprev, pm); }
    __syncthreads();
    const float L2E = 1.4426950408889634f;
    const float Mt = SM[t], winter = __builtin_amdgcn_exp2f((mprev - Mt) * L2E);
    f32x16 acc[4];
#pragma unroll
    for (int vt = 0; vt < 4; ++vt) { acc[vt] = (f32x16){};
#pragma unroll
        for (int d0 = 0; d0 < 4; ++d0) acc[vt] = __builtin_amdgcn_mfma_f32_32x32x16_bf16(cf[vt][d0], qf[d0], acc[vt], 0, 0, 0);
#pragma unroll
        for (int r = 0; r < 16; ++r) acc[vt][r] *= winter; }
    float den = 0.f;
    const LAS bf16* VT = (const LAS bf16*)VT32;
    for (int st = 0; st <= tb; ++st) {
        f32x16 S = {};
#pragma unroll
        for (int d0 = 0; d0 < 4; ++d0) { const bf16x8 A = *(const LAS bf16x8*)(KL + (st * 32 + l32) * 72 + d0 * 16 + 8 * hi);
            S = __builtin_amdgcn_mfma_f32_32x32x16_bf16(A, qf[d0], S, 0, 0, 0); }
        float p[16];
#pragma unroll
        for (int r = 0; r < 16; ++r) { const int sl = crow(r, hi); const float w = __builtin_amdgcn_exp2f((SA[st * 32 + sl] - Mt) * L2E); float pv = S[r] * w; if (st == tb && sl > l32) pv = 0.f; p[r] = pv; den += pv; }
        u32x4 pb0, pb1;
#pragma unroll
        for (int e = 0; e < 4; ++e) { pb0[e] = pk2(p[2 * e], p[2 * e + 1]); pb1[e] = pk2(p[8 + 2 * e], p[8 + 2 * e + 1]); }
#pragma unroll
        for (int vt = 0; vt < 4; ++vt) { const int rv = vt * 32 + l32;
            const u32x2 x0 = *(const LAS u32x2*)(VT + vt_off(rv, st * 4 + 0) + 4 * hi), x1 = *(const LAS u32x2*)(VT + vt_off(rv, st * 4 + 1) + 4 * hi), x2 = *(const LAS u32x2*)(VT + vt_off(rv, st * 4 + 2) + 4 * hi), x3 = *(const LAS u32x2*)(VT + vt_off(rv, st * 4 + 3) + 4 * hi);
            const u32x4 A0 = {x0.x, x0.y, x1.x, x1.y}, A1 = {x2.x, x2.y, x3.x, x3.y};
            acc[vt] = __builtin_amdgcn_mfma_f32_32x32x16_bf16(__builtin_bit_cast(bf16x8, A0), __builtin_bit_cast(bf16x8, pb0), acc[vt], 0, 0, 0);
            acc[vt] = __builtin_amdgcn_mfma_f32_32x32x16_bf16(__builtin_bit_cast(bf16x8, A1), __builtin_bit_cast(bf16x8, pb1), acc[vt], 0, 0, 0); }
    }
    den += __shfl_xor(den, 32);
    float qn = 0.f;
#pragma unroll
    for (int d0 = 0; d0 < 4; ++d0)
#pragma unroll
        for (int e = 0; e < 8; ++e) qn += bf2f((unsigned short)qf[d0][e]) * NP[d0 * 16 + 8 * hi + e];
    qn += __shfl_xor(qn, 32);
    den += winter * qn;
    const float mt = SB[t] + Mt;
    const float inv = 1.f / fmaxf(fabsf(den), __builtin_amdgcn_exp2f(-mt * L2E));
    float ss = 0.f;
#pragma unroll
    for (int vt = 0; vt < 4; ++vt)
#pragma unroll
        for (int r = 0; r < 16; ++r) { acc[vt][r] *= inv; ss += acc[vt][r] * acc[vt][r]; }
    ss += __shfl_xor(ss, 32);
    const float rn = 1.f / sqrtf(ss * (1.f / 128.f) + EPS);
    u32x4 ogr[8];
#pragma unroll
    for (int i = 0; i < 8; ++i) { const int rr = 4 * i + (lane >> 4), ch = lane & 15; ogr[i] = *(const u32x4*)(Z + (size_t)(row0 + tb * 32 + rr) * NZ + ZO + h * 128 + ch * 8); }
    __syncthreads();
    LAS bf16* STG = (LAS bf16*)lds + lw * 4352;
#pragma unroll
    for (int vt = 0; vt < 4; ++vt) {
        f32x4 g4[4];
#pragma unroll
        for (int rg = 0; rg < 4; ++rg) g4[rg] = *(const LAS f32x4*)(GM + vt * 32 + 8 * rg + 4 * hi);
#pragma unroll
        for (int rg = 0; rg < 4; ++rg) { const int v = vt * 32 + 8 * rg + 4 * hi;
            u32x2 o; o.x = pk2(acc[vt][4 * rg] * rn * g4[rg][0], acc[vt][4 * rg + 1] * rn * g4[rg][1]); o.y = pk2(acc[vt][4 * rg + 2] * rn * g4[rg][2], acc[vt][4 * rg + 3] * rn * g4[rg][3]);
            *(LAS u32x2*)(STG + l32 * 136 + v) = o; } }
    LDS_WAIT(); asm volatile("" ::: "memory");
#pragma unroll
    for (int i = 0; i < 8; ++i) { const int rr = 4 * i + (lane >> 4), ch = lane & 15; const u32x4 hw = *(const LAS u32x4*)(STG + rr * 136 + ch * 8); const u32x4 ow = ogr[i];
        u32x4 y;
#pragma unroll
        for (int e = 0; e < 4; ++e) y[e] = pk2(sigmoidf_(bflo(ow[e])) * bflo(hw[e]), sigmoidf_(bfhi(ow[e])) * bfhi(hw[e]));
        *(u32x4*)(YMIX + (size_t)(row0 + tb * 32 + rr) * DM + h * 128 + ch * 8) = y; }
    __syncthreads();
}
#define XB_TMO      128
#define XB_XCNT(j)  (256  + 64 * (j))
#define XB_XSUB(j)  (1280 + 64 * (j))
#define XB_XGEN(j)  (2304 + 64 * (j))
#define XB_TOP      3328
#define XB_TOPGEN   3392
#define XCD_BAR_WORDS 3456
#define XB_SPIN_CAP (1u << 18)

__device__ __forceinline__ unsigned xb_ld(unsigned* p)              { return __hip_atomic_load(p, __ATOMIC_RELAXED, __HIP_MEMORY_SCOPE_AGENT); }
__device__ __forceinline__ unsigned xb_add(unsigned* p, unsigned v) { return __hip_atomic_fetch_add(p, v, __ATOMIC_RELAXED, __HIP_MEMORY_SCOPE_AGENT); }
__device__ __forceinline__ unsigned xb_xcc_id() { return (unsigned)__builtin_amdgcn_s_getreg((3 << 11) | 20) & 0xFu; }
#define XB_SPIN(cond, bar) do { unsigned _sp = 0; while (cond) { __builtin_amdgcn_s_sleep(1); \
    if ((++_sp & 255u) == 0u) { if (xb_ld(&(bar)[XB_TMO])) break; if (_sp > XB_SPIN_CAP) { atomicAdd(&(bar)[XB_TMO], 1u); break; } } } } while (0)

struct XcdBarrier {
    unsigned* bar; unsigned x;
    volatile LAS unsigned* st;
};

__device__ __forceinline__ XcdBarrier xcd_barrier_post(unsigned* bar, volatile LAS unsigned* st) {
    XcdBarrier b; b.bar = bar; b.x = xb_xcc_id(); b.st = st;
    if (threadIdx.x == 0) (void)xb_add(&bar[XB_XCNT(b.x)], 1u);
    return b;
}
__device__ __forceinline__ void xcd_barrier_complete(unsigned* bar, unsigned x, unsigned& nloc, unsigned& nx) {
    const unsigned G = gridDim.x * gridDim.y * gridDim.z;
    unsigned sum, cnt, mine, sp = 0u;
    for (;;) {
        sum = 0u; cnt = 0u; mine = 0u;
#pragma unroll
        for (unsigned j = 0; j < 16; ++j) { const unsigned c = xb_ld(&bar[XB_XCNT(j)]); sum += c; cnt += (c > 0u) ? 1u : 0u; mine = (j == x) ? c : mine; }
        if (sum == G) break;
        __builtin_amdgcn_s_sleep(1);
        if ((++sp & 255u) == 0u) { if (xb_ld(&bar[XB_TMO])) break; if (sp > XB_SPIN_CAP) { atomicAdd(&bar[XB_TMO], 1u); break; } }
    }
    nloc = mine > 0u ? mine : 1u; nx = cnt > 0u ? cnt : 1u;
}

__device__ __forceinline__ void xcd_barrier(const XcdBarrier& b) {
    asm volatile("s_waitcnt vmcnt(0)" ::: "memory");
    __syncthreads();
    if (threadIdx.x == 0) {
        unsigned* bar = b.bar;
        __builtin_amdgcn_s_waitcnt(0);
        unsigned nloc = b.st[0], nx = b.st[1];
        if (nloc == 0u) { xcd_barrier_complete(bar, b.x, nloc, nx); b.st[0] = nloc; b.st[1] = nx; }
        const unsigned old = xb_add(&bar[XB_XSUB(b.x)], 1u);
        const unsigned gen = old / nloc;
        if (old + 1u == (gen + 1u) * nloc) {
            __builtin_amdgcn_fence(__ATOMIC_RELEASE, "agent");
            asm volatile("s_waitcnt vmcnt(0)" ::: "memory");
            const unsigned og = xb_add(&bar[XB_TOP], 1u);
            const unsigned tg = og / nx;
            if (og + 1u == (tg + 1u) * nx) xb_add(&bar[XB_TOPGEN], 1u);
            else XB_SPIN(xb_ld(&bar[XB_TOPGEN]) == tg, bar);
            __builtin_amdgcn_fence(__ATOMIC_ACQUIRE, "agent");
            xb_add(&bar[XB_XGEN(b.x)], 1u);
            asm volatile("s_waitcnt vmcnt(0)" ::: "memory");
        } else {
            XB_SPIN(xb_ld(&bar[XB_XGEN(b.x)]) == gen, bar);
            __builtin_amdgcn_fence(__ATOMIC_ACQUIRE, "agent");
            asm volatile("s_waitcnt vmcnt(0)" ::: "memory");
        }
    }
    __syncthreads();
}
__device__ __forceinline__ void swa_prompt_unit(const Args& a, LAS unsigned char* lds, int unit, int tid, int lane, int wave) {
    unsigned char* ws = a.ws;
    const bf16* Z = (const bf16*)(ws + WS_Z); bf16* YMIX = (bf16*)(ws + WS_ACTA);
    const int q4 = unit & 3, n = (unit >> 2) & 63, b = unit >> 8;
    LAS bf16* KL = (LAS bf16*)lds; LAS unsigned* VT32 = (LAS unsigned*)(lds + 46080); LAS float* SSP = (LAS float*)(lds + 89088);
    const int tok0 = n * 128 - 128 + q4 * 32;
    bf16x8 qf[4];
    { const int hq_ = wave, l32_ = lane & 31, hi_ = lane >> 5; const size_t row_ = (size_t)(b * SEQ + n * 128 + q4 * 32 + l32_);
#pragma unroll
      for (int d0 = 0; d0 < 4; ++d0) qf[d0] = *(const bf16x8*)(Z + row_ * NZ + ZQA + hq_ * 64 + d0 * 16 + 8 * hi_); }
#pragma unroll
    for (int i = 0; i < 5; ++i) { const int idx = tid + NTHR * i, ch = idx & 7, rk = idx >> 3, kv = rk / 160, lk = rk % 160, tok = tok0 + lk;
        u32x4 w = {0u, 0u, 0u, 0u}; if (tok >= 0) w = *(const u32x4*)(Z + (size_t)(b * SEQ + tok) * NZ + ZKA + kv * 64 + ch * 8);
        *(LAS u32x4*)(KL + (kv * 160 + lk) * 72 + ch * 8) = w; }
#pragma unroll
    for (int i = 0; i < 3; ++i) { const int idx = tid + NTHR * i;
        if (idx < 1280) { const int ch = idx & 7, rest = idx >> 3, kv = rest / 80, kp = rest % 80, tok = tok0 + 2 * kp;
            u32x4 a0 = {0u, 0u, 0u, 0u}, b0 = {0u, 0u, 0u, 0u};
            if (tok >= 0) { const bf16* p = Z + (size_t)(b * SEQ + tok) * NZ + ZVA + kv * 64 + ch * 8; a0 = *(const u32x4*)p; b0 = *(const u32x4*)(p + NZ); }
            LAS unsigned* d = VT32 + (kv * 64 + ch * 8) * 84 + kp;
#pragma unroll
            for (int e = 0; e < 4; ++e) { d[(2 * e) * 84] = (a0[e] & 0xffffu) | (b0[e] << 16); d[(2 * e + 1) * 84] = (a0[e] >> 16) | (b0[e] & 0xffff0000u); } } }
    __syncthreads();
    const int hq = wave, kv = hq >> 2, l32 = lane & 31, hi = lane >> 5;
    const float slope = exp2f(-(float)(hq + 1)), L2E = 1.4426950408889634f, sink2 = a.in[15][hq] * L2E;
    const LAS bf16* VT = (const LAS bf16*)VT32;
    const size_t row = (size_t)(b * SEQ + n * 128 + q4 * 32 + l32);
    f32x16 O[2];
    {
        float mrun = sink2, ls = 0.f;
        O[0] = (f32x16){}; O[1] = (f32x16){};
#pragma unroll 1
        for (int j = 0; j < 5; ++j) {
            f32x16 S = {};
#pragma unroll
            for (int d0 = 0; d0 < 4; ++d0) { const bf16x8 A = *(const LAS bf16x8*)(KL + (kv * 160 + 32 * j + l32) * 72 + d0 * 16 + 8 * hi);
                S = __builtin_amdgcn_mfma_f32_32x32x16_bf16(A, qf[d0], S, 0, 0, 0); }
            float mx = mrun;
#pragma unroll
            for (int r = 0; r < 16; ++r) { const int lk = 32 * j + crow(r, hi); const int dist = 128 + l32 - lk;
                const bool valid = dist >= 0 && dist <= 128 && (n > 0 || q4 * 32 + lk >= 128);
                const float sc = valid ? (S[r] * 0.125f - slope * (float)dist) * L2E : -INFINITY; S[r] = sc; mx = fmaxf(mx, sc); }
            mx = fmaxf(mx, __shfl_xor(mx, 32));
            const float alpha = __builtin_amdgcn_exp2f(mrun - mx); mrun = mx;
            float lt = 0.f;
#pragma unroll
            for (int r = 0; r < 16; ++r) { const float e = __builtin_amdgcn_exp2f(S[r] - mx); S[r] = e; lt += e; }
            ls = ls * alpha + lt;
            u32x4 pb0, pb1;
#pragma unroll
            for (int e = 0; e < 4; ++e) { pb0[e] = pk2(S[2 * e], S[2 * e + 1]); pb1[e] = pk2(S[8 + 2 * e], S[8 + 2 * e + 1]); }
#pragma unroll
            for (int dt = 0; dt < 2; ++dt) { const LAS bf16* vp = VT + (kv * 64 + dt * 32 + l32) * 168 + 32 * j + 4 * hi;
                const u32x2 x0 = *(const LAS u32x2*)vp, x1 = *(const LAS u32x2*)(vp + 8), x2 = *(const LAS u32x2*)(vp + 16), x3 = *(const LAS u32x2*)(vp + 24);
                const u32x4 A0 = {x0.x, x0.y, x1.x, x1.y}, A1 = {x2.x, x2.y, x3.x, x3.y};
#pragma unroll
                for (int r = 0; r < 16; ++r) O[dt][r] *= alpha;
                O[dt] = __builtin_amdgcn_mfma_f32_32x32x16_bf16(__builtin_bit_cast(bf16x8, A0), __builtin_bit_cast(bf16x8, pb0), O[dt], 0, 0, 0);
                O[dt] = __builtin_amdgcn_mfma_f32_32x32x16_bf16(__builtin_bit_cast(bf16x8, A1), __builtin_bit_cast(bf16x8, pb1), O[dt], 0, 0, 0); } }
        ls += __shfl_xor(ls, 32); ls += __builtin_amdgcn_exp2f(sink2 - mrun);
        const float il = 1.f / ls; float ss = 0.f;
#pragma unroll
        for (int dt = 0; dt < 2; ++dt)
#pragma unroll
            for (int r = 0; r < 16; ++r) { O[dt][r] *= il; ss += O[dt][r] * O[dt][r]; }
        ss += __shfl_xor(ss, 32);
        if (hi == 0) SSP[hq * 32 + l32] = ss;
    }
    __syncthreads();
    const float* ga = a.in[16];
    {
        float tot = 0.f;
#pragma unroll
        for (int q = 0; q < 8; ++q) tot += SSP[q * 32 + l32];
        const float rn = 1.f / sqrtf(tot * (1.f / 512.f) + EPS);
#pragma unroll
        for (int dt = 0; dt < 2; ++dt)
#pragma unroll
            for (int rg = 0; rg < 4; ++rg) { const int col = hq * 64 + dt * 32 + 8 * rg + 4 * hi; const f32x4 g4 = *(const f32x4*)(ga + col);
                u32x2 o; o.x = pk2(O[dt][4 * rg] * rn * g4[0], O[dt][4 * rg + 1] * rn * g4[1]); o.y = pk2(O[dt][4 * rg + 2] * rn * g4[2], O[dt][4 * rg + 3] * rn * g4[3]);
                *(u32x2*)(YMIX + row * DM + 512 + col) = o; }
    }
    __syncthreads();
}

__device__ __forceinline__ void mlstm_sample_prefetch(const Args& a, int unit, int tid, float (&cs)[16]) {
    const int dg = tid >> 7, v = tid & 127; const float* C0 = a.in[4] + (size_t)unit * 8192;
#pragma unroll
    for (int dd = 0; dd < 16; ++dd) cs[dd] = C0[(dg * 16 + dd) * 128 + v];
}
__device__ __forceinline__ void mlstm_sample_unit(const Args& a, LAS unsigned char* lds, int unit, int tid, int lane, int wave, const float (&cs)[16]) {
    unsigned char* ws = a.ws;
    const bf16* Z = (const bf16*)(ws + WS_Z); const float* GATES = (const float*)(ws + WS_GATES); bf16* YMIX = (bf16*)(ws + WS_ACTA);
    const int b = unit >> 2, h = unit & 3; const int rowb = MP + b * 4;
    LAS float* QS = (LAS float*)lds; LAS float* KS = QS + 256; LAS float* VS = QS + 512; LAS float* SR = QS + 1024; LAS float* QN = QS + 1040; LAS float* RED = QS + 1048; LAS float* PART = QS + 1056;
    const float* bg = a.in[12];
    const float m0 = a.in[6][unit];
    float ig[4], bc[4], av[4], Mt[4]; float run = 0.f, pm = -INFINITY;
#pragma unroll
    for (int t = 0; t < 4; ++t) { const float* gp = GATES + (size_t)(rowb + t) * 8; ig[t] = gp[h] + bg[h]; const float gf = gp[4 + h] + bg[4 + h];
        run += fminf(gf, 0.f) - log1pf(expf(-fabsf(gf))); bc[t] = run; av[t] = ig[t] - run; pm = fmaxf(pm, av[t]); Mt[t] = fmaxf(m0, pm); }
    const float blast = bc[3], mnew = fmaxf(blast + m0, blast + pm), decay = expf(blast + m0 - mnew);
    float wk[4];
#pragma unroll
    for (int s = 0; s < 4; ++s) wk[s] = expf(blast + av[s] - mnew);
    {
        const int t = tid >> 7, cl = tid & 127; const int col = cl < 64 ? h * 64 + cl : 256 + h * 64 + (cl - 64);
        const float* cb = a.in[7] + (size_t)b * 3 * 512; const float* cw = a.in[13];
        float x = 0.f, raw = 0.f;
#pragma unroll
        for (int j = 0; j < 4; ++j) { const int i = t + j; const float u = i < 3 ? cb[i * 512 + col] : bf2f(Z[(size_t)(rowb + i - 3) * NZ + ZQK + col]); x += cw[j * 512 + col] * u; if (j == 3) raw = u; }
        x = x * sigmoidf_(x);
        if (cl < 64) QS[t * 64 + cl] = x * 0.125f; else KS[t * 64 + cl - 64] = x;
        if (t >= 1) a.out[O_CONVS + ((size_t)b * 3 + (t - 1)) * 512 + col] = raw;
        VS[t * 128 + cl] = bf2f(Z[(size_t)(rowb + t) * NZ + ZV + h * 128 + cl]);
    }
    __syncthreads();
    if (tid < 16) { const int t = tid >> 2, s = tid & 3; float d = 0.f;
#pragma unroll 8
        for (int e = 0; e < 64; ++e) d += QS[t * 64 + e] * KS[s * 64 + e];
        SR[tid] = d; }
    else if (tid < 20) { const int t = tid - 16; const float* n0 = a.in[5] + (size_t)unit * 64; float d = 0.f;
#pragma unroll 8
        for (int e = 0; e < 64; ++e) d += QS[t * 64 + e] * n0[e];
        QN[t] = d; }
    else if (tid >= 64 && tid < 128) { const int d = tid - 64; float nn = decay * a.in[5][(size_t)unit * 64 + d];
#pragma unroll
        for (int s = 0; s < 4; ++s) nn += wk[s] * KS[s * 64 + d];
        a.out[O_NS + (size_t)unit * 64 + d] = nn; }
    if (tid == 0) a.out[O_MS + unit] = mnew;
    {
        const int dg = tid >> 7, v = tid & 127;
        float* CN = a.out + O_CS + (size_t)unit * 8192;
        float vv[4], part[4] = {0.f, 0.f, 0.f, 0.f};
#pragma unroll
        for (int s = 0; s < 4; ++s) vv[s] = VS[s * 128 + v] * wk[s];
#pragma unroll
        for (int dd = 0; dd < 16; ++dd) { const int d = dg * 16 + dd; const float c = cs[dd]; float cn = decay * c;
#pragma unroll
            for (int s = 0; s < 4; ++s) { part[s] += QS[s * 64 + d] * c; cn += KS[s * 64 + d] * vv[s]; }
            CN[d * 128 + v] = cn; }
#pragma unroll
        for (int t = 0; t < 4; ++t) PART[(dg * 4 + t) * 128 + v] = part[t];
    }
    __syncthreads();
    {
        const int t = tid >> 7, v = tid & 127;
        const float Mtt = t == 0 ? Mt[0] : t == 1 ? Mt[1] : t == 2 ? Mt[2] : Mt[3];
        const float bct = t == 0 ? bc[0] : t == 1 ? bc[1] : t == 2 ? bc[2] : bc[3];
        const float winter = expf(m0 - Mtt);
        const float qC = PART[(0 * 4 + t) * 128 + v] + PART[(1 * 4 + t) * 128 + v] + PART[(2 * 4 + t) * 128 + v] + PART[(3 * 4 + t) * 128 + v];
        float num = winter * qC, den = winter * QN[t];
#pragma unroll
        for (int s = 0; s < 4; ++s) { const float w = (s <= t) ? SR[t * 4 + s] * expf(av[s] - Mtt) : 0.f; num += w * VS[s * 128 + v]; den += w; }
        const float hv = num / fmaxf(fabsf(den), expf(-(bct + Mtt)));
        const float ssw = wave_sum(hv * hv);
        if (lane == 0) RED[wave] = ssw;
        __syncthreads();
        const float tot = RED[2 * t] + RED[2 * t + 1];
        const float y = hv / sqrtf(tot * (1.f / 128.f) + EPS) * a.in[14][h * 128 + v] * sigmoidf_(bf2f(Z[(size_t)(rowb + t) * NZ + ZO + h * 128 + v]));
        YMIX[(size_t)(rowb + t) * DM + h * 128 + v] = (bf16)(pk2(y, 0.f) & 0xffffu);
    }
    __syncthreads();
}

__device__ __forceinline__ void swa_sample_prefetch(const Args& a, int unit, int tid, f32x4 (&kq)[4], f32x4 (&vq)[4]) {
    const int b = unit >> 1, kv = unit & 1;
#pragma unroll
    for (int i = 0; i < 4; ++i) { const int ch = tid + NTHR * i, j = ch >> 4, d4 = (ch & 15) * 4; const size_t o = (((size_t)b * 128 + j) * 2 + kv) * 64 + d4; kq[i] = *(const f32x4*)(a.in[8] + o); vq[i] = *(const f32x4*)(a.in[9] + o); }
}
__device__ __forceinline__ void swa_sample_unit(const Args& a, LAS unsigned char* lds, int unit, int tid, int lane, int wave, const f32x4 (&kq)[4], const f32x4 (&vq)[4]) {
    unsigned char* ws = a.ws;
    const bf16* Z = (const bf16*)(ws + WS_Z); float* ATTS = (float*)(ws + WS_ATTS);
    LAS float* KA = (LAS float*)lds; LAS float* VA = KA + 132 * 65; LAS float* QS = VA + 132 * 65; LAS float* SC = QS + 16 * 65;
    const int b = unit >> 1, kv = unit & 1, rowb = MP + b * 4;
    {
#pragma unroll
        for (int i = 0; i < 4; ++i) { const int ch = tid + NTHR * i, j = ch >> 4, d4 = (ch & 15) * 4;
#pragma unroll
            for (int e = 0; e < 4; ++e) { KA[j * 65 + d4 + e] = kq[i][e]; VA[j * 65 + d4 + e] = vq[i][e]; }
            if (j >= 4) { const size_t o = (((size_t)b * 128 + (j - 4)) * 2 + kv) * 64 + d4; *(f32x4*)(a.out + O_KS + o) = kq[i]; *(f32x4*)(a.out + O_VS + o) = vq[i]; } }
        if (tid < 256) { const int j = 128 + (tid >> 6), d = tid & 63; const size_t zo = (size_t)(rowb + j - 128) * NZ + kv * 64 + d; const float kk = bf2f(Z[zo + ZKA]), vv = bf2f(Z[zo + ZVA]);
            KA[j * 65 + d] = kk; VA[j * 65 + d] = vv; const size_t o = (((size_t)b * 128 + (j - 4)) * 2 + kv) * 64 + d; a.out[O_KS + o] = kk; a.out[O_VS + o] = vv; }
#pragma unroll
        for (int i = 0; i < 2; ++i) { const int idx = tid + NTHR * i, r = idx >> 6, d = idx & 63, g = r >> 2, t = r & 3;
            QS[r * 65 + d] = bf2f(Z[(size_t)(rowb + t) * NZ + ZQA + (kv * 4 + g) * 64 + d]); }
    }
    __syncthreads();
    { const int r = tid & 15, kk = tid >> 4, g = r >> 2, i = r & 3; const float slope = exp2f(-(float)(kv * 4 + g + 1));
#pragma unroll
      for (int jj = 0; jj < 5; ++jj) { const int key = kk + 32 * jj;
          if (key < 132) { float d = 0.f;
#pragma unroll 16
              for (int e = 0; e < 64; ++e) d += QS[r * 65 + e] * KA[key * 65 + e];
              const int dist = 128 + i - key; SC[r * 136 + key] = (dist >= 0 && dist <= 128) ? d * 0.125f - slope * (float)dist : -INFINITY; } } }
    __syncthreads();
    { const int r = tid >> 5, l = tid & 31, g = r >> 2; const float sink = a.in[15][kv * 4 + g];
      float sc[5]; float mx = sink;
#pragma unroll
      for (int jj = 0; jj < 5; ++jj) { const int key = l + 32 * jj; sc[jj] = key < 132 ? SC[r * 136 + key] : -INFINITY; mx = fmaxf(mx, sc[jj]); }
#pragma unroll
      for (int o = 1; o < 32; o <<= 1) mx = fmaxf(mx, __shfl_xor(mx, o));
      float sm = 0.f;
#pragma unroll
      for (int jj = 0; jj < 5; ++jj) { sc[jj] = expf(sc[jj] - mx); sm += sc[jj]; }
#pragma unroll
      for (int o = 1; o < 32; o <<= 1) sm += __shfl_xor(sm, o);
      const float inv = 1.f / (sm + expf(sink - mx));
#pragma unroll
      for (int jj = 0; jj < 5; ++jj) { const int key = l + 32 * jj; if (key < 132) SC[r * 136 + key] = sc[jj] * inv; } }
    __syncthreads();
    { const int r = tid >> 5, d = (tid & 31) * 2, g = r >> 2, i = r & 3; float o0 = 0.f, o1 = 0.f;
#pragma unroll 12
      for (int s = 0; s < 132; ++s) { const float p = SC[r * 136 + s]; o0 += p * VA[s * 65 + d]; o1 += p * VA[s * 65 + d + 1]; }
      float* op = ATTS + (size_t)(b * 4 + i) * 512 + (kv * 4 + g) * 64 + d; op[0] = o0; op[1] = o1; }
    __syncthreads();
}
__device__ __forceinline__ void swa_sample_norm(const Args& a, int lane, int wave) {
    unsigned char* ws = a.ws; const float* ATTS = (const float*)(ws + WS_ATTS); bf16* YMIX = (bf16*)(ws + WS_ACTA);
    const int gw = blockIdx.x * NWAVES + wave, NGW = gridDim.x * NWAVES;
    for (int r = gw; r < MS; r += NGW) {
        const f32x4 v0 = *(const f32x4*)(ATTS + (size_t)r * 512 + 8 * lane), v1 = *(const f32x4*)(ATTS + (size_t)r * 512 + 8 * lane + 4);
        const float ss = wave_sum((v0[0] * v0[0] + v0[1] * v0[1]) + (v0[2] * v0[2] + v0[3] * v0[3]) + (v1[0] * v1[0] + v1[1] * v1[1]) + (v1[2] * v1[2] + v1[3] * v1[3]));
        const float rn = 1.f / sqrtf(ss * (1.f / 512.f) + EPS);
        const f32x4 g0 = *(const f32x4*)(a.in[16] + 8 * lane), g1 = *(const f32x4*)(a.in[16] + 8 * lane + 4);
        u32x4 o; o.x = pk2(v0[0] * rn * g0[0], v0[1] * rn * g0[1]); o.y = pk2(v0[2] * rn * g0[2], v0[3] * rn * g0[3]); o.z = pk2(v1[0] * rn * g1[0], v1[1] * rn * g1[1]); o.w = pk2(v1[2] * rn * g1[2], v1[3] * rn * g1[3]);
        *(u32x4*)(YMIX + (size_t)(MP + r) * DM + 512 + 8 * lane) = o;
    }
}

__device__ __forceinline__ void misc_outputs(const Args& a, int tid) {
    const bf16* Z = (const bf16*)(a.ws + WS_Z);
    const int gt = blockIdx.x * NTHR + tid, NT = gridDim.x * NTHR;
    for (int i = gt; i < 2 * 128 * 128; i += NT) { const int b = i >> 14, j = (i >> 7) & 127, cidx = i & 127; const size_t zr = (size_t)(b * SEQ + SEQ - 128 + j) * NZ;
        a.out[O_KP + i] = bf2f(Z[zr + ZKA + cidx]); a.out[O_VP + i] = bf2f(Z[zr + ZVA + cidx]); }
    for (int i = gt; i < 2 * 3 * 512; i += NT) { const int b = i / 1536, j = (i / 512) % 3, cidx = i & 511;
        a.out[O_CONVP + i] = bf2f(Z[(size_t)(b * SEQ + SEQ - 3 + j) * NZ + ZQK + cidx]); }
}

__device__ __forceinline__ bf16* d1_row(unsigned char* ws, int m) { return m < MP ? (bf16*)(ws + WS_D1P) + (size_t)m * DM : (bf16*)(ws + WS_D1S) + (size_t)(m - MP) * DM; }
__device__ __forceinline__ void rowpass_mix(const Args& a, int lane, int wave) {
    unsigned char* ws = a.ws; const bf16* MIXS = (const bf16*)(ws + WS_MIXS); bf16* U = (bf16*)(ws + WS_ACTA);
    const int gw = blockIdx.x * NWAVES + wave, NGW = gridDim.x * NWAVES;
    f32x4 gp[4], gf[4];
#pragma unroll
    for (int j = 0; j < 2; ++j) { const int c0 = 8 * lane + 512 * j; gp[2 * j] = *(const f32x4*)(a.in[18] + c0); gp[2 * j + 1] = *(const f32x4*)(a.in[18] + c0 + 4); gf[2 * j] = *(const f32x4*)(a.in[19] + c0); gf[2 * j + 1] = *(const f32x4*)(a.in[19] + c0 + 4); }
    for (int grp = MP / 4 + gw; grp < MT / 4; grp += NGW) {
        u32x4 mw[4][2]; f32x4 xv[4][4];
#pragma unroll
        for (int r = 0; r < 4; ++r) { const int m = grp * 4 + r; const float* xr = m < MP ? a.in[0] + (size_t)m * DM : a.in[1] + (size_t)(m - MP) * DM;
#pragma unroll
            for (int j = 0; j < 2; ++j) { const int c0 = 8 * lane + 512 * j; mw[r][j] = *(const u32x4*)(MIXS + (size_t)(m - MP) * DM + c0); xv[r][2 * j] = *(const f32x4*)(xr + c0); xv[r][2 * j + 1] = *(const f32x4*)(xr + c0 + 4); } }
#pragma unroll
        for (int r = 0; r < 4; ++r) { const int m = grp * 4 + r;
            f32x4 mv[4]; float s = 0.f;
#pragma unroll
            for (int j = 0; j < 2; ++j) { mv[2 * j] = (f32x4){bflo(mw[r][j][0]), bfhi(mw[r][j][0]), bflo(mw[r][j][1]), bfhi(mw[r][j][1])}; mv[2 * j + 1] = (f32x4){bflo(mw[r][j][2]), bfhi(mw[r][j][2]), bflo(mw[r][j][3]), bfhi(mw[r][j][3])}; }
#pragma unroll
            for (int q = 0; q < 4; ++q) s += (mv[q][0] * mv[q][0] + mv[q][1] * mv[q][1]) + (mv[q][2] * mv[q][2] + mv[q][3] * mv[q][3]);
            const float rs = 1.f / sqrtf(wave_sum(s) * (1.f / DM) + EPS);
            float s1 = 0.f;
#pragma unroll
            for (int q = 0; q < 4; ++q) { mv[q] = mv[q] * gp[q] * rs; xv[r][q] = xv[r][q] + mv[q]; s1 += (xv[r][q][0] * xv[r][q][0] + xv[r][q][1] * xv[r][q][1]) + (xv[r][q][2] * xv[r][q][2] + xv[r][q][3] * xv[r][q][3]); }
            const float rs1 = 1.f / sqrtf(wave_sum(s1) * (1.f / DM) + EPS);
#pragma unroll
            for (int j = 0; j < 2; ++j) { const int c0 = 8 * lane + 512 * j;
                { u32x4 dd; dd.x = pk2(xv[r][2 * j][0], xv[r][2 * j][1]); dd.y = pk2(xv[r][2 * j][2], xv[r][2 * j][3]); dd.z = pk2(xv[r][2 * j + 1][0], xv[r][2 * j + 1][1]); dd.w = pk2(xv[r][2 * j + 1][2], xv[r][2 * j + 1][3]);
                  *(u32x4*)(d1_row(ws, m) + c0) = dd; }
                const f32x4 u0 = xv[r][2 * j] * gf[2 * j] * rs1, u1 = xv[r][2 * j + 1] * gf[2 * j + 1] * rs1;
                u32x4 o; o.x = pk2(u0[0], u0[1]); o.y = pk2(u0[2], u0[3]); o.z = pk2(u1[0], u1[1]); o.w = pk2(u1[2], u1[3]);
                *(u32x4*)(U + (size_t)m * DM + c0) = o; }
        }
    }
}
__device__ __forceinline__ void rowpass_ffn(const Args& a, int lane, int wave) {
    unsigned char* ws = a.ws; bf16* Fb = (bf16*)(ws + WS_ACTA);
    const int gw = blockIdx.x * NWAVES + wave, NGW = gridDim.x * NWAVES;
    f32x4 gp[4];
#pragma unroll
    for (int j = 0; j < 2; ++j) { const int c0 = 8 * lane + 512 * j; gp[2 * j] = *(const f32x4*)(a.in[22] + c0); gp[2 * j + 1] = *(const f32x4*)(a.in[22] + c0 + 4); }
    for (int grp = MP / 4 + gw; grp < MT / 4; grp += NGW) {
        u32x4 fw[4][2], dw[4][2];
#pragma unroll
        for (int r = 0; r < 4; ++r) { const int m = grp * 4 + r; const bf16* dr = d1_row(ws, m);
#pragma unroll
            for (int j = 0; j < 2; ++j) { const int c0 = 8 * lane + 512 * j; fw[r][j] = *(const u32x4*)(Fb + (size_t)m * DM + c0); dw[r][j] = *(const u32x4*)(dr + c0); } }
#pragma unroll
        for (int r = 0; r < 4; ++r) { const int m = grp * 4 + r;
            f32x4 fv[4]; float s = 0.f;
#pragma unroll
            for (int j = 0; j < 2; ++j) { fv[2 * j] = (f32x4){bflo(fw[r][j][0]), bfhi(fw[r][j][0]), bflo(fw[r][j][1]), bfhi(fw[r][j][1])}; fv[2 * j + 1] = (f32x4){bflo(fw[r][j][2]), bfhi(fw[r][j][2]), bflo(fw[r][j][3]), bfhi(fw[r][j][3])}; }
#pragma unroll
            for (int q = 0; q < 4; ++q) s += (fv[q][0] * fv[q][0] + fv[q][1] * fv[q][1]) + (fv[q][2] * fv[q][2] + fv[q][3] * fv[q][3]);
            const float rs = 1.f / sqrtf(wave_sum(s) * (1.f / DM) + EPS);
#pragma unroll
            for (int j = 0; j < 2; ++j) { const int c0 = 8 * lane + 512 * j;
                const f32x4 d0 = {bflo(dw[r][j][0]), bfhi(dw[r][j][0]), bflo(dw[r][j][1]), bfhi(dw[r][j][1])}, d1 = {bflo(dw[r][j][2]), bfhi(dw[r][j][2]), bflo(dw[r][j][3]), bfhi(dw[r][j][3])};
                const f32x4 x0 = d0 + fv[2 * j] * gp[2 * j] * rs, x1 = d1 + fv[2 * j + 1] * gp[2 * j + 1] * rs;
                u32x4 o; o.x = pk2(x0[0], x0[1]); o.y = pk2(x0[2], x0[3]); o.z = pk2(x1[0], x1[1]); o.w = pk2(x1[2], x1[3]);
                *(u32x4*)((bf16*)(ws + WS_X2) + (size_t)m * DM + c0) = o; }
        }
    }
}
struct SkBf16 { bf16* O; int ldc; int act;
    __device__ __forceinline__ void operator()(int row, int col, f32x4 v) const {
        if (act == 2) {
#pragma unroll
            for (int e = 0; e < 4; ++e) { const float t = v[e] > 0.f ? v[e] : 0.f; v[e] = t * t; } }
        u32x2 o; o.x = pk2(v[0], v[1]); o.y = pk2(v[2], v[3]); *(u32x2*)(O + (size_t)row * ldc + col) = o; } };
struct SkFinal { float* out; const bf16* PP; const bf16* X2;
    __device__ __forceinline__ void operator()(int row, int col, f32x4 v) const {
        const size_t o = (size_t)row * DM + col; const u32x2 xw = *(const u32x2*)(X2 + o); const f32x4 xs = {bflo(xw.x), bfhi(xw.x), bflo(xw.y), bfhi(xw.y)}; const u32x2 pw = *(const u32x2*)(PP + o);
        f32x4 r; r[0] = xs[0] + bflo(pw.x) * sigmoidf_(v[0]); r[1] = xs[1] + bfhi(pw.x) * sigmoidf_(v[1]); r[2] = xs[2] + bflo(pw.y) * sigmoidf_(v[2]); r[3] = xs[3] + bfhi(pw.y) * sigmoidf_(v[3]);
        *(f32x4*)(out + o) = r; } };
struct SkNormX { float* xbuf; unsigned* cnt; const bf16* X1; const float* g; bf16* X2; };
__device__ __forceinline__ void skinny_norm_epilogue(const SkNormX& nx, LAS float* SSQ  , LAS float* RS  , int r0, int c0, int rloc, int col, f32x4 v, int tid, int lane, int wave) {
    const int rb = r0 >> 6, cb = c0 >> 5;
    SSQ[128 + rloc * 8 + (((col - c0) >> 2) & 7)] = (v[0] * v[0] + v[1] * v[1]) + (v[2] * v[2] + v[3] * v[3]);
    __syncthreads();
    if (tid < 64) { const LAS float* pp = SSQ + 128 + tid * 8; const float t = ((pp[0] + pp[1]) + (pp[2] + pp[3])) + ((pp[4] + pp[5]) + (pp[6] + pp[7]));
        __hip_atomic_store(nx.xbuf + ((size_t)(rb * 64 + tid) * 32 + cb), t, __ATOMIC_RELAXED, __HIP_MEMORY_SCOPE_AGENT); }
    if (wave == 0) { asm volatile("s_waitcnt vmcnt(0)" ::: "memory");
        if (lane == 0) __hip_atomic_fetch_add(nx.cnt + 64 * rb, 1u, __ATOMIC_RELAXED, __HIP_MEMORY_SCOPE_AGENT);
        unsigned sp = 0u;
        for (;;) { if ((unsigned)__builtin_amdgcn_readfirstlane(__hip_atomic_load(nx.cnt + 64 * rb, __ATOMIC_RELAXED, __HIP_MEMORY_SCOPE_AGENT)) >= 32u) break;
            if (++sp > (1u << 21)) break;
            __builtin_amdgcn_s_sleep(2); }
        __builtin_amdgcn_fence(__ATOMIC_ACQUIRE, "agent"); }
    asm volatile("s_waitcnt vmcnt(0) lgkmcnt(0)" ::: "memory"); __syncthreads();
    { const int row = tid >> 3, part = tid & 7; const float* slot = nx.xbuf + (size_t)(rb * 64 + row) * 32 + part * 4; float t = 0.f;
#pragma unroll
      for (int q = 0; q < 4; ++q) t += __hip_atomic_load(slot + q, __ATOMIC_RELAXED, __HIP_MEMORY_SCOPE_AGENT);
      t += __shfl_xor(t, 1); t += __shfl_xor(t, 2); t += __shfl_xor(t, 4);
      if (part == 0) RS[row] = 1.f / sqrtf(t * (1.f / 1024.f) + EPS); }
    __syncthreads();
    const float rs = RS[rloc];
    const size_t o = (size_t)(r0 + rloc) * DM + col; const u32x2 xw = *(const u32x2*)(nx.X1 + o); const f32x4 g4 = *(const f32x4*)(nx.g + col);
    u32x2 w; w.x = pk2(bflo(xw.x) + v[0] * rs * g4[0], bfhi(xw.x) + v[1] * rs * g4[1]); w.y = pk2(bflo(xw.y) + v[2] * rs * g4[2], bfhi(xw.y) + v[3] * rs * g4[3]);
    *(u32x2*)(nx.X2 + o) = w;
}
template <int KC, class Epi>
__device__ __forceinline__ void skinny_gemm(LAS unsigned char* lds, const bf16* A, const bf16* Bt, int N, int K, const Epi& E, int tid, int lane, int wave, int first = -1, int stride = 0) {
    constexpr int PITCH = KC * 2 + 16, APC = KC / 8, NA = 64 * APC / NTHR, NB = 32 * APC / NTHR, STEPS = KC / 128;
    LAS unsigned char* AS = lds; LAS unsigned char* BS = lds + 64 * PITCH;
    LAS float* PART = (LAS float*)lds;
    const int ntiles = 8 * (N / 32), l32 = lane & 31, hi = lane >> 5, nch = K / KC;
    if (first < 0) { first = blockIdx.x; stride = gridDim.x; }
    for (int tile = first; tile < ntiles; tile += stride) {
        int r0 = (tile & 7) * 64, c0 = (tile >> 3) * 32;
        if (stride == 256) { const int bxx = tile & 255, it = tile >> 8; r0 = ((bxx >> 3) & 7) * 64; c0 = (it * 32 + (bxx >> 6) * 8 + (bxx & 7)) * 32; }
        f32x16 acc0 = {}, acc1 = {};
        u32x4 ra[NA], rb[NB];
#define SK_LOADG(chk) do { \
        _Pragma("unroll") for (int i = 0; i < NA; ++i) { const int p = tid + NTHR * i, row = p / APC, pc = p % APC; ra[i] = *(const u32x4*)(A + (size_t)(r0 + row) * K + (chk) * KC + pc * 8); } \
        _Pragma("unroll") for (int i = 0; i < NB; ++i) { const int p = tid + NTHR * i, row = p / APC, pc = p % APC; rb[i] = *(const u32x4*)(Bt + (size_t)(c0 + row) * K + (chk) * KC + pc * 8); } } while (0)
        SK_LOADG(0);
        for (int ch = 0; ch < nch; ++ch) {
#pragma unroll
            for (int i = 0; i < NA; ++i) { const int p = tid + NTHR * i, row = p / APC, pc = p % APC; *(LAS u32x4*)(AS + row * PITCH + pc * 16) = ra[i]; }
#pragma unroll
            for (int i = 0; i < NB; ++i) { const int p = tid + NTHR * i, row = p / APC, pc = p % APC; *(LAS u32x4*)(BS + row * PITCH + pc * 16) = rb[i]; }
            if (ch + 1 < nch) SK_LOADG(ch + 1);
            __syncthreads();
#pragma unroll
            for (int s = 0; s < STEPS; ++s) { const int koff = (wave * (KC / 8) + s * 16 + 8 * hi) * 2;
                const bf16x8 b = *(const LAS bf16x8*)(BS + l32 * PITCH + koff), a0 = *(const LAS bf16x8*)(AS + l32 * PITCH + koff), a1 = *(const LAS bf16x8*)(AS + (32 + l32) * PITCH + koff);
                acc0 = __builtin_amdgcn_mfma_f32_32x32x16_bf16(b, a0, acc0, 0, 0, 0); acc1 = __builtin_amdgcn_mfma_f32_32x32x16_bf16(b, a1, acc1, 0, 0, 0); }
            __syncthreads();
        }
#undef SK_LOADG
#pragma unroll
        for (int r = 0; r < 16; ++r) { PART[((wave * 2 + 0) * 16 + r) * 64 + lane] = acc0[r]; PART[((wave * 2 + 1) * 16 + r) * 64 + lane] = acc1[r]; }
        __syncthreads();
        { const int i = tid >> 8, rq = (tid >> 6) & 3, ln = tid & 63; f32x4 v = {0.f, 0.f, 0.f, 0.f};
#pragma unroll
          for (int w = 0; w < 8; ++w)
#pragma unroll
              for (int e = 0; e < 4; ++e) v[e] += PART[((w * 2 + i) * 16 + 4 * rq + e) * 64 + ln];
          if constexpr (__is_same(Epi, SkNormX)) { LAS float* SSQ = (LAS float*)(lds + 65536); LAS float* RS = SSQ + 64;
              skinny_norm_epilogue(E, SSQ, RS, r0, c0, 32 * i + (ln & 31), c0 + 8 * rq + 4 * (ln >> 5), v, tid, lane, wave); }
          else E(r0 + 32 * i + (ln & 31), c0 + 8 * rq + 4 * (ln >> 5), v); }
        __syncthreads();
    }
}

template <class Epi>
__device__ __forceinline__ void skinny_gemm128(LAS unsigned char* lds, const bf16* A, const bf16* Bt, int N, int K, const Epi& E, int tid, int lane, int wave, int first = -1, int stride = 0) {
    constexpr int KC = 256, PITCH = KC * 2 + 16, APC = KC / 8, NA = 128 * APC / NTHR, NB = 64 * APC / NTHR;
    LAS unsigned char* AS = lds; LAS unsigned char* BS = lds + 128 * PITCH;
    const int ntiles = 4 * (N / 64), l32 = lane & 31, hi = lane >> 5, nch = K / KC, rbk = wave >> 1, cbk = wave & 1;
    if (first < 0) { first = blockIdx.x; stride = gridDim.x; }
    for (int tile = first; tile < ntiles; tile += stride) {
        const int r0 = (tile & 3) * 128, c0 = (tile >> 2) * 64;
        f32x16 acc = {};
        u32x4 ra[NA], rb[NB];
#define SK_LOADG(chk) do { \
        _Pragma("unroll") for (int i = 0; i < NA; ++i) { const int p = tid + NTHR * i, row = p / APC, pc = p % APC; ra[i] = *(const u32x4*)(A + (size_t)(r0 + row) * K + (chk) * KC + pc * 8); } \
        _Pragma("unroll") for (int i = 0; i < NB; ++i) { const int p = tid + NTHR * i, row = p / APC, pc = p % APC; rb[i] = *(const u32x4*)(Bt + (size_t)(c0 + row) * K + (chk) * KC + pc * 8); } } while (0)
        SK_LOADG(0);
        for (int ch = 0; ch < nch; ++ch) {
#pragma unroll
            for (int i = 0; i < NA; ++i) { const int p = tid + NTHR * i, row = p / APC, pc = p % APC; *(LAS u32x4*)(AS + row * PITCH + pc * 16) = ra[i]; }
#pragma unroll
            for (int i = 0; i < NB; ++i) { const int p = tid + NTHR * i, row = p / APC, pc = p % APC; *(LAS u32x4*)(BS + row * PITCH + pc * 16) = rb[i]; }
            if (ch + 1 < nch) SK_LOADG(ch + 1);
            __syncthreads();
#pragma unroll
            for (int s = 0; s < KC / 16; ++s) { const int koff = (s * 16 + 8 * hi) * 2;
                const bf16x8 b = *(const LAS bf16x8*)(BS + (cbk * 32 + l32) * PITCH + koff), a = *(const LAS bf16x8*)(AS + (rbk * 32 + l32) * PITCH + koff);
                acc = __builtin_amdgcn_mfma_f32_32x32x16_bf16(b, a, acc, 0, 0, 0); }
            __syncthreads();
        }
#undef SK_LOADG
#pragma unroll
        for (int rg = 0; rg < 4; ++rg) E(r0 + rbk * 32 + l32, c0 + cbk * 32 + 8 * rg + 4 * hi, (f32x4){acc[4 * rg], acc[4 * rg + 1], acc[4 * rg + 2], acc[4 * rg + 3]});
    }
}
constexpr int N_PHASES = 11;
__global__ void __launch_bounds__(NTHR) hymba_fwd(Args args) {
    extern __shared__ __attribute__((aligned(16))) unsigned char lds_raw[];
    LAS unsigned char* lds = (LAS unsigned char*)lds_raw;
    const int tid = threadIdx.x, lane = tid & 63, wave = __builtin_amdgcn_readfirstlane(tid >> 6);
    const int G = gridDim.x, bx = blockIdx.x;
    unsigned char* ws = args.ws;
    const int lo = args.ph_lo, hi = args.ph_hi;
#ifndef PHMASK
#define PHMASK 0x7ff
#endif
#define IN(k) (((PHMASK >> (k)) & 1) && lo <= (k) && (k) < hi)
    if (tid < 256) ((LAS unsigned*)(lds + 131072))[tid] = 0u;
    __syncthreads();
    XcdBarrier bar; bar.bar = (unsigned*)(ws + WS_CTL); bar.x = 0; bar.st = nullptr;
    if (args.coop) bar = xcd_barrier_post((unsigned*)(ws + WS_CTL), (volatile LAS unsigned*)(lds + MISC_OFF) + 8);
    if (args.pad == 0x5a5a) cg::this_grid().sync();
#define SEAM(k) do { if (args.coop && IN((k) + 1)) { xcd_barrier(bar); } } while (0)
    bf16* ACTA = (bf16*)(ws + WS_ACTA);
    if (IN(0)) { p0_prologue(args, lds, tid, lane, wave); SEAM(0); }
    if (IN(1)) {
        const int skf = (G == 256) ? (bx >= 64 ? bx - 64 : (1 << 28)) : bx, sks = (G == 256) ? 192 : G;
        { SkBf16 E{(bf16*)(ws + WS_Z) + (size_t)MP * NZ, NZ, 0}; skinny_gemm<512>(lds, ACTA + (size_t)MP * DM, (const bf16*)(ws + WS_WIN), NZ, DM, E, tid, lane, wave, skf, sks); }
        { SkBf16 E{(bf16*)(ws + WS_PP) + (size_t)MP * DM, DM, 0}; skinny_gemm<256>(lds, (const bf16*)(ws + WS_PBF) + (size_t)MP * PD, (const bf16*)(ws + WS_WPP), DM, PD, E, tid, lane, wave, skf, sks); }
        { pg8::Gemm g{ACTA, (const bf16*)(ws + WS_WIN), MP, NZ, DM}; pg8::StaticOrder S; S.init(MP, NZ, G, bx);
          pg8::EpiBf16<0> E{(bf16*)(ws + WS_Z), NZ};
          pg8::gemm_phase<pg8::EpiBf16<0>, pg8::StaticOrder, true, true>(lds, g, S, E); }
        { pg8::Gemm g{(const bf16*)(ws + WS_PBF), (const bf16*)(ws + WS_WPP), MP, DM, PD}; pg8::StaticOrder S; S.init(MP, DM, 192, bx >= 64 ? bx - 64 : 1 << 20);
          pg8::EpiBf16<0> E{(bf16*)(ws + WS_PP), DM};
          pg8::gemm_phase<pg8::EpiBf16<0>, pg8::StaticOrder, true, true>(lds, g, S, E); }
        SEAM(1);
    }
    if (IN(2)) {
        if (G == 256) {
            float cs0[16], cs1[16]; f32x4 kq[4], vq[4];
            mlstm_sample_prefetch(args, bx, tid, cs0); mlstm_sample_prefetch(args, bx + 256, tid, cs1); swa_sample_prefetch(args, bx, tid, kq, vq);
            mlstm_b1_unit(args, lds, bx, tid, lane, wave); mlstm_b1_unit(args, lds, bx + 256, tid, lane, wave);
            mlstm_sample_unit(args, lds, bx, tid, lane, wave, cs0); mlstm_sample_unit(args, lds, bx + 256, tid, lane, wave, cs1);
            swa_sample_unit(args, lds, bx, tid, lane, wave, kq, vq);
        } else {
            for (int u = bx; u < 512; u += G) mlstm_b1_unit(args, lds, u, tid, lane, wave);
            for (int u = bx; u < 512; u += G) { float cs0[16]; mlstm_sample_prefetch(args, u, tid, cs0); mlstm_sample_unit(args, lds, u, tid, lane, wave, cs0); }
            for (int u = bx; u < 256; u += G) { f32x4 kq[4], vq[4]; swa_sample_prefetch(args, u, tid, kq, vq); swa_sample_unit(args, lds, u, tid, lane, wave, kq, vq); }
        }
        SEAM(2);
    }
    if (IN(3)) {
        if (!(args.pad & 1)) mlstm_scan(args, tid);
        if (bx >= 129) { transpose_items(args, lds, IT_EARLY, IT_ALL, (bx - 129) * NWAVES + wave, (G - 129) * NWAVES, lane, wave); __syncthreads(); }
        if (!(args.pad & 2)) {
            if (G == 256) {
                const int vcu = (bx & 7) * 32 + (bx >> 3);
                swa_prompt_unit(args, lds, 2 * vcu, tid, lane, wave); swa_prompt_unit(args, lds, 2 * vcu + 1, tid, lane, wave);
            } else for (int u = bx; u < 512; u += G) swa_prompt_unit(args, lds, u, tid, lane, wave);
        }
        if (!(args.pad & 4)) { misc_outputs(args, tid); swa_sample_norm(args, lane, wave); }
        SEAM(3);
    }
    if (IN(4)) {
        for (int u = 2 * bx; u < 512; u += 2 * G) mlstm_b3_pair(args, lds, u, tid, lane, wave);
        { SkBf16 E{(bf16*)(ws + WS_MIXS), DM, 0}; skinny_gemm<512>(lds, ACTA + (size_t)MP * DM, (const bf16*)(ws + WS_WOUT), DM, DM, E, tid, lane, wave); }
        SEAM(4);
    }
    if (IN(5)) {
        rowpass_mix(args, lane, wave);
        pg8::Gemm g{ACTA, (const bf16*)(ws + WS_WOUT), MP, DM, DM}; pg8::StaticOrder S; S.init(MP, DM, G, bx);
        unsigned* cb = (unsigned*)(ws + WS_CTL + 16384); float* xb = (float*)(ws + WS_XBUF);
        pg8::EpiMixNorm E{args.in[18], args.in[19], (bf16*)(ws + WS_D1P), ACTA, DM, EPS, pg8::RowSumSq{xb, cb}, pg8::RowSumSq{xb + 65536, cb + 4096}};
        pg8::gemm_phase<pg8::EpiMixNorm, pg8::StaticOrder, false, true>(lds, g, S, E);
        SEAM(6);
    }
    if (IN(7)) {
        { SkBf16 E2{(bf16*)(ws + WS_H) + (size_t)MP * FF, FF, 2}; skinny_gemm128(lds, ACTA + (size_t)MP * DM, (const bf16*)(ws + WS_WUP), FF, DM, E2, tid, lane, wave); }
        pg8::Gemm g{ACTA, (const bf16*)(ws + WS_WUP), MP, FF, DM}; pg8::StaticOrder S; S.init(MP, FF, G, bx);
        pg8::EpiBf16<2> E{(bf16*)(ws + WS_H), FF};
        pg8::gemm_phase<pg8::EpiBf16<2>, pg8::StaticOrder, true, true>(lds, g, S, E);
        SEAM(7);
    }
    if (IN(8)) {
        { SkNormX E2{(float*)(ws + WS_XBUF) + 196608, (unsigned*)(ws + WS_CTL + 16384) + 12288, (const bf16*)(ws + WS_D1S), args.in[22], ACTA + (size_t)MP * DM};
          skinny_gemm<512>(lds, (const bf16*)(ws + WS_H) + (size_t)MP * FF, (const bf16*)(ws + WS_WDN), DM, FF, E2, tid, lane, wave); }
        pg8::Gemm g{(const bf16*)(ws + WS_H), (const bf16*)(ws + WS_WDN), MP, DM, FF}; pg8::StaticOrder S; S.init(MP, DM, G, bx);
        pg8::EpiFfnNorm E{(const bf16*)(ws + WS_D1P), args.in[22], ACTA, DM, EPS, pg8::RowSumSq{(float*)(ws + WS_XBUF) + 131072, (unsigned*)(ws + WS_CTL + 16384) + 8192}};
        pg8::gemm_phase<pg8::EpiFfnNorm, pg8::StaticOrder, false, true>(lds, g, S, E);
        SEAM(9);
    }
    if (IN(10)) {
        const bf16* X2 = ACTA;
        { SkFinal E{args.out + (size_t)MP * DM, (const bf16*)(ws + WS_PP) + (size_t)MP * DM, X2 + (size_t)MP * DM}; skinny_gemm<512>(lds, X2 + (size_t)MP * DM, (const bf16*)(ws + WS_WPG), DM, DM, E, tid, lane, wave); }
        pg8::Gemm g{X2, (const bf16*)(ws + WS_WPG), MP, DM, DM}; pg8::StaticOrder S; S.init(MP, DM, G, bx);
        pg8::EpiFinal E{args.out, (const bf16*)(ws + WS_PP), X2, DM};
        pg8::gemm_phase<pg8::EpiFinal, pg8::StaticOrder, true, true>(lds, g, S, E);
    }
#undef IN
#undef SEAM
}

#ifndef REP_MASK
#define REP_MASK 0
#endif
#ifndef REP_SKIP
#define REP_SKIP 0
#endif
#ifndef MK_SINGLE
#define MK_SINGLE 1
#endif
extern "C" void kernel_launch(void* const* d_in, const int* in_sizes, int n_in, void* d_out, int out_size, void* d_ws, size_t ws_size, hipStream_t stream) {
    static int grid = 0;
    if (grid == 0) {
        if (n_in != 25 || out_size != (int)O_END || ws_size < WS_END) { fprintf(stderr, "kernel_launch: unexpected shapes: n_in %d out %d ws %zu\n", n_in, out_size, ws_size); grid = -1; return; }
        int dev = 0, cus = 0, per_cu = 0;
        hipGetDevice(&dev); hipDeviceGetAttribute(&cus, hipDeviceAttributeMultiprocessorCount, dev);
        if (hipFuncSetAttribute((const void*)hymba_fwd, hipFuncAttributeMaxDynamicSharedMemorySize, LDS_BYTES) != hipSuccess) { fprintf(stderr, "kernel_launch: hipFuncSetAttribute failed\n"); grid = -1; return; }
        hipOccupancyMaxActiveBlocksPerMultiprocessor(&per_cu, (const void*)hymba_fwd, NTHR, LDS_BYTES);
        (void)hipGetLastError();
        if (per_cu < 1) per_cu = 1;
        grid = cus * 1;
        fprintf(stderr, "kernel_launch: cus %d per_cu %d grid %d\n", cus, per_cu, grid);
    }
    if (grid < 0) return;
    if (hipMemsetAsync((char*)d_ws + WS_CTL, 0, CTL_BYTES, stream) != hipSuccess) { fprintf(stderr, "kernel_launch: memset failed\n"); return; }
    Args a{};
    for (int i = 0; i < 25; ++i) a.in[i] = (const float*)d_in[i];
    a.out = (float*)d_out; a.ws = (unsigned char*)d_ws;
#if MK_SINGLE
    a.ph_lo = 0; a.ph_hi = N_PHASES; a.coop = 1;
    void* kargs[] = {&a};
    hipError_t e = hipLaunchCooperativeKernel((const void*)hymba_fwd, dim3(grid), dim3(NTHR), kargs, LDS_BYTES, stream);
    if (e != hipSuccess) fprintf(stderr, "cooperative launch failed: %s (grid %d)\n", hipGetErrorString(e), grid);
#else
    for (int p = 0; p < N_PHASES; ++p) { a.ph_lo = p; a.ph_hi = p + 1; a.coop = 0;
        for (int r = 0; r < (((REP_MASK >> p) & 1) ? 2 : 1); ++r) { a.pad = r ? REP_SKIP : 0; hipLaunchKernelGGL(hymba_fwd, dim3(grid), dim3(NTHR), LDS_BYTES, stream, a); } }
#endif
}
```

```cpp
#include <hip/hip_runtime.h>
#include <hip/hip_cooperative_groups.h>
#include <cstdio>
#include <cstdint>
namespace cg = cooperative_groups;
namespace pg8 {
#define PG8_LAS __attribute__((address_space(3)))
typedef unsigned short bf16_t;
typedef short bf16x8 __attribute__((ext_vector_type(8)));
typedef float f32x4 __attribute__((ext_vector_type(4)));
typedef unsigned u32x4 __attribute__((ext_vector_type(4)));
constexpr int BM = 256, BK = 64, HALF = 128, HTB = HALF * BK * 2  , STAGE_BYTES = 8 * HTB, NXCD = 8, WGM = 8;

__host__ __device__ __forceinline__ int lds_byte(int r, int c) { const int st = (r >> 4) * 2 + (c >> 5), rr = r & 15, cc = c & 31, ob = rr * 64 + cc * 2; return st * 1024 + (ob ^ (((ob >> 9) & 1) << 5)); }
__host__ __device__ __forceinline__ void stage_rc(int b, int& R, int& C) { const int st = b / 1024, sb = b % 1024, swz = sb ^ (((sb >> 9) & 1) << 5); R = (st >> 1) * 16 + swz / 64; C = (st & 1) * 32 + (swz % 64) / 2; }
__host__ __device__ __forceinline__ int perm32(int rho) { const int n = rho >> 4, i = rho & 15; return 8 * (i >> 2) + 4 * n + (i & 3); }

struct Unit { int pm, pn; };
struct Gemm { const bf16_t* A; const bf16_t* Bt; int M, N, K; };

struct StaticOrder {
    int nM, nN, nwg, G, c;
    __host__ __device__ void init(int M, int N, int G_, int c_) { nM = M / BM; nN = N / BM; nwg = nM * nN; G = G_; c = c_; }
    __host__ __device__ bool next(int i, Unit& u) const {
        const long L = (long)i * G + c; if (L >= nwg) return false;
        int wgid = (int)L; { const int q = nwg / NXCD, r = nwg % NXCD, xcd = wgid % NXCD, off = wgid / NXCD; wgid = (xcd < r ? xcd * (q + 1) : r * (q + 1) + (xcd - r) * q) + off; }
        const int nig = WGM * nN, gid = wgid / nig, fm = gid * WGM, gsz = (nM - fm) < WGM ? (nM - fm) : WGM;
        u.pm = fm + ((wgid % nig) % gsz); u.pn = (wgid % nig) / gsz; return true;
    }
    __device__ __forceinline__ void a_ready(const Unit&) const {}
    __device__ __forceinline__ void done(const Unit&) const {}
};

__device__ __forceinline__ unsigned cvt_pk_bf16(float lo, float hi) { unsigned r; asm volatile("v_cvt_pk_bf16_f32 %0, %1, %2" : "=v"(r) : "v"(lo), "v"(hi)); return r; }
template <int ACT> struct EpiBf16 {
    static constexpr bool PERM = true, AFTER_DRAIN = false;
    bf16_t* O; int ldc;
    __device__ __forceinline__ void operator()(const f32x4 (&acc)[2][2][4][2], const Unit& u, int wr, int wc, int fr, int fq) const {
        const int row0 = u.pm * BM + wr * 64 + fr; const int col0 = u.pn * BM + wc * 32 + 8 * fq;
#pragma unroll
        for (int ai = 0; ai < 2; ++ai)
#pragma unroll
            for (int m = 0; m < 4; ++m) { bf16_t* rowp = O + (size_t)(row0 + ai * HALF + m * 16) * ldc + col0;
#pragma unroll
                for (int bj = 0; bj < 2; ++bj) { f32x4 v0 = acc[ai][bj][m][0], v1 = acc[ai][bj][m][1];
                    if (ACT == 2) {
#pragma unroll
                        for (int e = 0; e < 4; ++e) { float a = v0[e] > 0.f ? v0[e] : 0.f; v0[e] = a * a; float b = v1[e] > 0.f ? v1[e] : 0.f; v1[e] = b * b; } }
                    u32x4 w; w.x = cvt_pk_bf16(v0[0], v0[1]); w.y = cvt_pk_bf16(v0[2], v0[3]); w.z = cvt_pk_bf16(v1[0], v1[1]); w.w = cvt_pk_bf16(v1[2], v1[3]);
                    *(u32x4*)(rowp + bj * HALF) = w; } }
    }
};
struct EpiFinal {
    static constexpr bool PERM = true, AFTER_DRAIN = false;
    float* out; const bf16_t* PP; const bf16_t* X2; int ldc;
    __device__ __forceinline__ void operator()(const f32x4 (&acc)[2][2][4][2], const Unit& u, int wr, int wc, int fr, int fq) const {
        const int col0 = u.pn * BM + wc * 32 + 8 * fq;
        u32x4 xs[2][2], pw[2][2];
#define EF_LOAD(gi, buf) do { const int ai_ = (gi) >> 2, m_ = (gi) & 3; const size_t off_ = (size_t)(u.pm * BM + ai_ * HALF + wr * 64 + m_ * 16 + fr) * ldc + col0; \
        _Pragma("unroll") for (int q = 0; q < 2; ++q) { xs[buf][q] = *(const u32x4*)(X2 + off_ + q * HALF); pw[buf][q] = *(const u32x4*)(PP + off_ + q * HALF); } } while (0)
        EF_LOAD(0, 0);
#pragma unroll
        for (int gi = 0; gi < 8; ++gi) {
            if (gi + 1 < 8) EF_LOAD(gi + 1, (gi + 1) & 1);
            asm volatile("" ::: "memory");
            const int ai = gi >> 2, m = gi & 3; const size_t off = (size_t)(u.pm * BM + ai * HALF + wr * 64 + m * 16 + fr) * ldc + col0;
#pragma unroll
            for (int bj = 0; bj < 2; ++bj) { const u32x4 w = pw[gi & 1][bj], xw = xs[gi & 1][bj];
#pragma unroll
                for (int n = 0; n < 2; ++n) { const f32x4 a = acc[ai][bj][m][n]; const unsigned wa = n ? w.z : w.x, wb = n ? w.w : w.y, xa = n ? xw.z : xw.x, xb = n ? xw.w : xw.y;
                    f32x4 p, xf; p[0] = __uint_as_float(wa << 16); p[1] = __uint_as_float(wa & 0xffff0000u); p[2] = __uint_as_float(wb << 16); p[3] = __uint_as_float(wb & 0xffff0000u);
                    xf[0] = __uint_as_float(xa << 16); xf[1] = __uint_as_float(xa & 0xffff0000u); xf[2] = __uint_as_float(xb << 16); xf[3] = __uint_as_float(xb & 0xffff0000u);
                    f32x4 res;
#pragma unroll
                    for (int e = 0; e < 4; ++e) res[e] = xf[e] + p[e] * __builtin_amdgcn_rcpf(1.f + __expf(-a[e]));
                    *(f32x4*)(out + off + bj * HALF + n * 4) = res; } }
        }
#undef EF_LOAD
    }
};
struct RowSumSq {
    float* xbuf;
    unsigned* cnt;
    __device__ __forceinline__ void run(const f32x4 (&v)[2][2][4][2], const Unit& u, int wr, int wc, int fr, int fq, PG8_LAS unsigned char* lds, int wid, int lane) const {
        PG8_LAS float* P = (PG8_LAS float*)lds;
        PG8_LAS float* S = (PG8_LAS float*)(lds + 4096);
#pragma unroll
        for (int ai = 0; ai < 2; ++ai)
#pragma unroll
            for (int m = 0; m < 4; ++m) { float s = 0.f;
#pragma unroll
                for (int bj = 0; bj < 2; ++bj)
#pragma unroll
                    for (int n = 0; n < 2; ++n) { const f32x4 x = v[ai][bj][m][n]; s += (x[0] * x[0] + x[1] * x[1]) + (x[2] * x[2] + x[3] * x[3]); }
                s += __shfl_xor(s, 16); s += __shfl_xor(s, 32);
                if (fq == 0) P[(ai * HALF + wr * 64 + m * 16 + fr) * 4 + wc] = s; }
        asm volatile("s_waitcnt lgkmcnt(0)" ::: "memory"); __builtin_amdgcn_s_barrier(); asm volatile("" ::: "memory");
        const int row = wid * 32 + (lane & 31);
        if (lane < 32) { const float t = (P[row * 4 + 0] + P[row * 4 + 1]) + (P[row * 4 + 2] + P[row * 4 + 3]);
            __hip_atomic_store(xbuf + ((size_t)(u.pm * BM + row) * 4 + u.pn), t, __ATOMIC_RELAXED, __HIP_MEMORY_SCOPE_AGENT); }
        asm volatile("s_waitcnt vmcnt(0)" ::: "memory");
        if (lane == 0) __hip_atomic_fetch_add(cnt + 64 * u.pm, 1u, __ATOMIC_RELAXED, __HIP_MEMORY_SCOPE_AGENT);
        if (wid == 0) { unsigned sp = 0u;
            for (;;) { if ((unsigned)__builtin_amdgcn_readfirstlane(__hip_atomic_load(cnt + 64 * u.pm, __ATOMIC_RELAXED, __HIP_MEMORY_SCOPE_AGENT)) >= 32u) break;
                if (++sp > (1u << 21)) break;
                __builtin_amdgcn_s_sleep(2); }
            __builtin_amdgcn_fence(__ATOMIC_ACQUIRE, "agent"); }
        asm volatile("s_waitcnt vmcnt(0) lgkmcnt(0)" ::: "memory"); __builtin_amdgcn_s_barrier(); asm volatile("" ::: "memory");
        if (lane < 32) { const float* slot = xbuf + (size_t)(u.pm * BM + row) * 4;
            const float t0 = __hip_atomic_load(slot + 0, __ATOMIC_RELAXED, __HIP_MEMORY_SCOPE_AGENT), t1 = __hip_atomic_load(slot + 1, __ATOMIC_RELAXED, __HIP_MEMORY_SCOPE_AGENT);
            const float t2 = __hip_atomic_load(slot + 2, __ATOMIC_RELAXED, __HIP_MEMORY_SCOPE_AGENT), t3 = __hip_atomic_load(slot + 3, __ATOMIC_RELAXED, __HIP_MEMORY_SCOPE_AGENT);
            S[row] = (t0 + t1) + (t2 + t3); }
        asm volatile("s_waitcnt lgkmcnt(0)" ::: "memory"); __builtin_amdgcn_s_barrier(); asm volatile("" ::: "memory");
    }
};
struct EpiMixNorm {
    static constexpr bool PERM = true, AFTER_DRAIN = true;
    const float* gpost; const float* gffn; bf16_t* X1; bf16_t* U; int ldc; float eps; RowSumSq st1, st2;
    __device__ __forceinline__ void fused(f32x4 (&acc)[2][2][4][2], const Unit& u, int wr, int wc, int fr, int fq, PG8_LAS unsigned char* lds, int wid, int lane) const {
        const PG8_LAS float* S = (const PG8_LAS float*)(lds + 4096);
        const int col0 = u.pn * BM + wc * 32 + 8 * fq;
        st1.run(acc, u, wr, wc, fr, fq, lds, wid, lane);
        f32x4 gv[2][2];
#pragma unroll
        for (int bj = 0; bj < 2; ++bj)
#pragma unroll
            for (int n = 0; n < 2; ++n) gv[bj][n] = *(const f32x4*)(gpost + col0 + bj * HALF + n * 4);
#pragma unroll
        for (int ai = 0; ai < 2; ++ai)
#pragma unroll
            for (int m = 0; m < 4; ++m) { const int r = ai * HALF + wr * 64 + m * 16 + fr; const float rs = 1.0f / sqrtf(S[r] * (1.0f / 1024.0f) + eps); const size_t off = (size_t)(u.pm * BM + r) * ldc + col0;
#pragma unroll
                for (int bj = 0; bj < 2; ++bj) { const u32x4 xw = *(const u32x4*)(X1 + off + bj * HALF);
                    f32x4 x0, x1; x0[0] = __uint_as_float(xw.x << 16); x0[1] = __uint_as_float(xw.x & 0xffff0000u); x0[2] = __uint_as_float(xw.y << 16); x0[3] = __uint_as_float(xw.y & 0xffff0000u);
                    x1[0] = __uint_as_float(xw.z << 16); x1[1] = __uint_as_float(xw.z & 0xffff0000u); x1[2] = __uint_as_float(xw.w << 16); x1[3] = __uint_as_float(xw.w & 0xffff0000u);
                    acc[ai][bj][m][0] = x0 + acc[ai][bj][m][0] * gv[bj][0] * rs; acc[ai][bj][m][1] = x1 + acc[ai][bj][m][1] * gv[bj][1] * rs; }
                asm volatile("" : "+v"(acc[ai][0][m][0]), "+v"(acc[ai][0][m][1]), "+v"(acc[ai][1][m][0]), "+v"(acc[ai][1][m][1]));
                if (m & 1) asm volatile("" ::: "memory"); }
        st2.run(acc, u, wr, wc, fr, fq, lds, wid, lane);
#pragma unroll
        for (int bj = 0; bj < 2; ++bj)
#pragma unroll
            for (int n = 0; n < 2; ++n) gv[bj][n] = *(const f32x4*)(gffn + col0 + bj * HALF + n * 4);
#pragma unroll
        for (int ai = 0; ai < 2; ++ai)
#pragma unroll
            for (int m = 0; m < 4; ++m) { const int r = ai * HALF + wr * 64 + m * 16 + fr; const float rs = 1.0f / sqrtf(S[r] * (1.0f / 1024.0f) + eps); const size_t off = (size_t)(u.pm * BM + r) * ldc + col0;
#pragma unroll
                for (int bj = 0; bj < 2; ++bj) { const f32x4 a0 = acc[ai][bj][m][0], a1 = acc[ai][bj][m][1]; const f32x4 o0 = a0 * gv[bj][0] * rs, o1 = a1 * gv[bj][1] * rs; const size_t oo = off + bj * HALF;
                    u32x4 w1; w1.x = cvt_pk_bf16(a0[0], a0[1]); w1.y = cvt_pk_bf16(a0[2], a0[3]); w1.z = cvt_pk_bf16(a1[0], a1[1]); w1.w = cvt_pk_bf16(a1[2], a1[3]); *(u32x4*)(X1 + oo) = w1;
                    u32x4 w2; w2.x = cvt_pk_bf16(o0[0], o0[1]); w2.y = cvt_pk_bf16(o0[2], o0[3]); w2.z = cvt_pk_bf16(o1[0], o1[1]); w2.w = cvt_pk_bf16(o1[2], o1[3]); *(u32x4*)(U + oo) = w2; } }
    }
};
struct EpiFfnNorm {
    static constexpr bool PERM = true, AFTER_DRAIN = true;
    const bf16_t* X1; const float* g; bf16_t* X2; int ldc; float eps; RowSumSq st;
    __device__ __forceinline__ void fused(f32x4 (&acc)[2][2][4][2], const Unit& u, int wr, int wc, int fr, int fq, PG8_LAS unsigned char* lds, int wid, int lane) const {
        const PG8_LAS float* S = (const PG8_LAS float*)(lds + 4096);
        const int col0 = u.pn * BM + wc * 32 + 8 * fq;
        st.run(acc, u, wr, wc, fr, fq, lds, wid, lane);
        f32x4 gv[2][2];
#pragma unroll
        for (int bj = 0; bj < 2; ++bj)
#pragma unroll
            for (int n = 0; n < 2; ++n) gv[bj][n] = *(const f32x4*)(g + col0 + bj * HALF + n * 4);
#pragma unroll
        for (int ai = 0; ai < 2; ++ai)
#pragma unroll
            for (int m = 0; m < 4; ++m) { const int r = ai * HALF + wr * 64 + m * 16 + fr; const float rs = 1.0f / sqrtf(S[r] * (1.0f / 1024.0f) + eps); const size_t off = (size_t)(u.pm * BM + r) * ldc + col0;
#pragma unroll
                for (int bj = 0; bj < 2; ++bj) { const size_t oo = off + bj * HALF; const u32x4 xw = *(const u32x4*)(X1 + oo);
                    f32x4 x0, x1; x0[0] = __uint_as_float(xw.x << 16); x0[1] = __uint_as_float(xw.x & 0xffff0000u); x0[2] = __uint_as_float(xw.y << 16); x0[3] = __uint_as_float(xw.y & 0xffff0000u);
                    x1[0] = __uint_as_float(xw.z << 16); x1[1] = __uint_as_float(xw.z & 0xffff0000u); x1[2] = __uint_as_float(xw.w << 16); x1[3] = __uint_as_float(xw.w & 0xffff0000u);
                    const f32x4 o0 = x0 + acc[ai][bj][m][0] * gv[bj][0] * rs, o1 = x1 + acc[ai][bj][m][1] * gv[bj][1] * rs;
                    u32x4 w; w.x = cvt_pk_bf16(o0[0], o0[1]); w.y = cvt_pk_bf16(o0[2], o0[3]); w.z = cvt_pk_bf16(o1[0], o1[1]); w.w = cvt_pk_bf16(o1[2], o1[3]); *(u32x4*)(X2 + oo) = w; }
                if (m & 1) asm volatile("" ::: "memory"); }
    }
};
template <class Epi, class Sched, bool ALIGN_EPI = false, bool SP2 = false>
__device__ __forceinline__ void gemm_phase(PG8_LAS unsigned char* lds, const Gemm g, const Sched& S, const Epi& E) {
    const int tid = threadIdx.x, wid = __builtin_amdgcn_readfirstlane(tid >> 6), lane = tid & 63, wr = wid >> 2, wc = wid & 3, fr = lane & 15, fq = lane >> 4;
    const int K = g.K, nt = K / BK;
    unsigned voffA[2], voffB[2];
#pragma unroll
    for (int i = 0; i < 2; ++i) { int R, C; stage_rc(tid * 16 + i * 8192, R, C); const int Rb = Epi::PERM ? ((R & ~31) + perm32(R & 31)) : R;
        voffA[i] = (unsigned)(R * K + C) * 2u; voffB[i] = (unsigned)(Rb * K + C) * 2u; }
    const size_t kstep = (size_t)(BK * 2);
    const size_t hstep = (size_t)HALF * K * 2;
    const size_t tstep = 2 * hstep;
    const unsigned ldsw = (unsigned)wid * 1024u;
    const int aoff = lds_byte(wr * 64 + fr, fq * 8), boff = lds_byte(wc * 32 + fr, fq * 8);
#define PG8_SA(b, h) (((b) * 2 + (h)) * HTB)
#define PG8_SB(b, h) ((4 + (b) * 2 + (h)) * HTB)
#define PG8_STAGE(bufoff, gbase, voff) do { _Pragma("unroll") for (int _i = 0; _i < 2; ++_i) \
        __builtin_amdgcn_global_load_lds((const unsigned*)((const char*)(gbase) + (voff)[_i]), (PG8_LAS unsigned*)(lds + (bufoff) + ldsw + _i * 8192), 16, 0, 0); } while (0)
#define PG8_LDA(dst, b, h) do { _Pragma("unroll") for (int m = 0; m < 4; ++m) _Pragma("unroll") for (int k = 0; k < 2; ++k) dst[m][k] = *(const PG8_LAS bf16x8*)(lds + PG8_SA(b, h) + aoff + m * 2048 + k * 1024); } while (0)
#define PG8_LDB(dst, b, h) do { _Pragma("unroll") for (int n = 0; n < 2; ++n) _Pragma("unroll") for (int k = 0; k < 2; ++k) dst[n][k] = *(const PG8_LAS bf16x8*)(lds + PG8_SB(b, h) + boff + n * 2048 + k * 1024); } while (0)
#define PG8_MMA(ai, bj, At, Bt) do { __builtin_amdgcn_s_setprio(1); _Pragma("unroll") for (int m = 0; m < 4; ++m) _Pragma("unroll") for (int n = 0; n < 2; ++n) _Pragma("unroll") for (int k = 0; k < 2; ++k) \
        acc[ai][bj][m][n] = __builtin_amdgcn_mfma_f32_16x16x32_bf16(Bt[n][k], At[m][k], acc[ai][bj][m][n], 0, 0, 0); __builtin_amdgcn_s_setprio(0); } while (0)
#define PG8_WAIT_V(n) asm volatile("s_waitcnt vmcnt(" #n ")" ::: "memory")
#define PG8_WAIT_L(n) asm volatile("s_waitcnt lgkmcnt(" #n ")" ::: "memory")
#define PG8_BAR __builtin_amdgcn_s_barrier()
#define PG8_SCHED __builtin_amdgcn_sched_barrier(0)
    Unit cur, nxt; int ui = 0;
    if (!S.next(0, cur)) return;
    f32x4 acc[2][2][4][2];
#pragma unroll
    for (int a = 0; a < 2; ++a)
#pragma unroll
        for (int b = 0; b < 2; ++b)
#pragma unroll
            for (int m = 0; m < 4; ++m)
#pragma unroll
                for (int n = 0; n < 2; ++n) acc[a][b][m][n] = (f32x4){0.f, 0.f, 0.f, 0.f};
    bf16x8 At[4][2], B0[2][2], B1[2][2];
    const char* cA = (const char*)g.A + (size_t)cur.pm * tstep; const char* cB = (const char*)g.Bt + (size_t)cur.pn * tstep;
    S.a_ready(cur);
    if constexpr (SP2) {
        PG8_STAGE(PG8_SB(0, 0), cB, voffB); PG8_STAGE(PG8_SB(0, 1), cB + hstep, voffB); PG8_STAGE(PG8_SA(0, 0), cA, voffA); PG8_STAGE(PG8_SA(0, 1), cA + hstep, voffA);
        if (wr == 1) PG8_BAR;
        PG8_WAIT_V(2); PG8_BAR;
        PG8_STAGE(PG8_SB(1, 0), cB + kstep, voffB); PG8_STAGE(PG8_SA(1, 0), cA + kstep, voffA); PG8_STAGE(PG8_SB(1, 1), cB + hstep + kstep, voffB);
        PG8_WAIT_V(6); PG8_BAR;
    } else {
        PG8_STAGE(PG8_SB(0, 0), cB, voffB); PG8_STAGE(PG8_SA(0, 0), cA, voffA); PG8_STAGE(PG8_SB(0, 1), cB + hstep, voffB); PG8_STAGE(PG8_SA(0, 1), cA + hstep, voffA);
        if (wr == 1) PG8_BAR;
        PG8_WAIT_V(4); PG8_BAR;
        PG8_STAGE(PG8_SB(1, 0), cB + kstep, voffB); PG8_STAGE(PG8_SA(1, 0), cA + kstep, voffA); PG8_STAGE(PG8_SB(1, 1), cB + hstep + kstep, voffB);
        PG8_WAIT_V(6); PG8_BAR;
    }
    for (;;) {
        const bool has_next = S.next(ui + 1, nxt);
        const char* nA = has_next ? (const char*)g.A + (size_t)nxt.pm * tstep : cA; const char* nB = has_next ? (const char*)g.Bt + (size_t)nxt.pn * tstep : cB;
        for (int t = 0; t < nt; t += 2) {
            const bool last = (t == nt - 2);
            const char* a1 = cA + (size_t)(t + 1) * kstep;
            const char* a2 = last ? nA : cA + (size_t)(t + 2) * kstep; const char* b2 = last ? nB : cB + (size_t)(t + 2) * kstep;
            const char* a3 = a2 + kstep; const char* b3 = b2 + kstep;
            if (last && has_next) S.a_ready(nxt);
            if constexpr (SP2) {
            PG8_LDB(B0, 0, 0); PG8_LDB(B1, 0, 1); PG8_SCHED; PG8_LDA(At, 0, 0); PG8_STAGE(PG8_SA(1, 1), a1 + hstep, voffA);
            PG8_WAIT_V(8); PG8_WAIT_L(0); PG8_BAR; PG8_MMA(0, 0, At, B0); PG8_MMA(0, 1, At, B1); PG8_BAR; PG8_SCHED;
            PG8_LDA(At, 0, 1); PG8_STAGE(PG8_SB(0, 0), b2, voffB); PG8_STAGE(PG8_SB(0, 1), b2 + hstep, voffB); PG8_STAGE(PG8_SA(0, 0), a2, voffA);
            PG8_WAIT_V(8); PG8_WAIT_L(0); PG8_BAR; PG8_MMA(1, 0, At, B0); PG8_MMA(1, 1, At, B1); PG8_BAR; PG8_SCHED;
            PG8_LDB(B0, 1, 0); PG8_LDB(B1, 1, 1); PG8_SCHED; PG8_LDA(At, 1, 0); PG8_STAGE(PG8_SA(0, 1), a2 + hstep, voffA);
            PG8_WAIT_V(8); PG8_WAIT_L(0); PG8_BAR; PG8_MMA(0, 0, At, B0); PG8_MMA(0, 1, At, B1); PG8_BAR; PG8_SCHED;
            PG8_LDA(At, 1, 1); PG8_STAGE(PG8_SB(1, 0), b3, voffB); PG8_STAGE(PG8_SB(1, 1), b3 + hstep, voffB); PG8_STAGE(PG8_SA(1, 0), a3, voffA);
            PG8_WAIT_V(8); PG8_WAIT_L(0); PG8_BAR; PG8_MMA(1, 0, At, B0); PG8_MMA(1, 1, At, B1); PG8_BAR; PG8_SCHED;
            } else {
            PG8_LDB(B0, 0, 0); PG8_SCHED; PG8_LDA(At, 0, 0); PG8_STAGE(PG8_SA(1, 1), a1 + hstep, voffA);
            PG8_WAIT_L(8); PG8_BAR; PG8_WAIT_L(0); PG8_MMA(0, 0, At, B0); PG8_BAR; PG8_SCHED;
            PG8_LDB(B1, 0, 1); PG8_STAGE(PG8_SB(0, 0), b2, voffB);
            PG8_BAR; PG8_WAIT_L(0); PG8_MMA(0, 1, At, B1); PG8_BAR;
            PG8_LDA(At, 0, 1); PG8_STAGE(PG8_SA(0, 0), a2, voffA);
            PG8_BAR; PG8_WAIT_L(0); PG8_MMA(1, 0, At, B0); PG8_BAR; PG8_SCHED;
            PG8_STAGE(PG8_SB(0, 1), b2 + hstep, voffB);
            PG8_WAIT_V(6); PG8_BAR; PG8_MMA(1, 1, At, B1); PG8_BAR;
            PG8_LDB(B0, 1, 0); PG8_SCHED; PG8_LDA(At, 1, 0); PG8_STAGE(PG8_SA(0, 1), a2 + hstep, voffA);
            PG8_WAIT_L(8); PG8_BAR; PG8_WAIT_L(0); PG8_MMA(0, 0, At, B0); PG8_BAR; PG8_SCHED;
            PG8_LDB(B1, 1, 1); PG8_STAGE(PG8_SB(1, 0), b3, voffB);
            PG8_BAR; PG8_WAIT_L(0); PG8_MMA(0, 1, At, B1); PG8_BAR;
            PG8_LDA(At, 1, 1); PG8_STAGE(PG8_SA(1, 0), a3, voffA);
            PG8_BAR; PG8_WAIT_L(0); PG8_MMA(1, 0, At, B0); PG8_BAR; PG8_SCHED;
            PG8_STAGE(PG8_SB(1, 1), b3 + hstep, voffB);
            PG8_WAIT_V(6); PG8_BAR; PG8_MMA(1, 1, At, B1); PG8_BAR;
            }
        }
        if constexpr (ALIGN_EPI) { if (wr == 0) PG8_BAR; }
        if constexpr (!Epi::AFTER_DRAIN) { E(acc, cur, wr, wc, fr, fq); S.done(cur); }
        if (!has_next) break;
#pragma unroll
        for (int a = 0; a < 2; ++a)
#pragma unroll
            for (int b = 0; b < 2; ++b)
#pragma unroll
                for (int m = 0; m < 4; ++m)
#pragma unroll
                    for (int n = 0; n < 2; ++n) acc[a][b][m][n] = (f32x4){0.f, 0.f, 0.f, 0.f};
        cur = nxt; cA = nA; cB = nB; ++ui;
        if constexpr (ALIGN_EPI) { if (wr == 1) PG8_BAR; }
    }
    PG8_WAIT_V(0);
    if constexpr (!ALIGN_EPI) { if (wr == 0) PG8_BAR; }
    PG8_BAR;
    if constexpr (Epi::AFTER_DRAIN) { E.fused(acc, cur, wr, wc, fr, fq, lds, wid, lane); S.done(cur); }
#undef PG8_SA
#undef PG8_SB
#undef PG8_STAGE
#undef PG8_LDA
#undef PG8_LDB
#undef PG8_MMA
#undef PG8_WAIT_V
#undef PG8_WAIT_L
#undef PG8_BAR
#undef PG8_SCHED
}
}
#define LAS __attribute__((address_space(3)))
typedef unsigned short bf16;
typedef float f32x4 __attribute__((ext_vector_type(4)));
typedef float f32x16 __attribute__((ext_vector_type(16)));
typedef short bf16x8 __attribute__((ext_vector_type(8)));
typedef short s16x4 __attribute__((ext_vector_type(4)));
typedef unsigned u32x4 __attribute__((ext_vector_type(4)));
typedef unsigned u32x2 __attribute__((ext_vector_type(2)));
#define LDS_WAIT() asm volatile("s_waitcnt lgkmcnt(0)" ::: "memory")

constexpr int MP = 16384, MS = 512, MT = MP + MS, DM = 1024, NZ = 2304, FF = 4096, PD = 256, SEQ = 8192, PROJ_W = 2312;
constexpr int ZQK = 0, ZV = 512, ZO = 1024, ZQA = 1536, ZKA = 2048, ZVA = 2176;
constexpr float EPS = 1e-6f;
constexpr int NWAVES = 8, NTHR = 512;
constexpr int LDS_BYTES = 147456;
constexpr size_t MiB = 1u << 20;
constexpr size_t WS_WIN = 0, WS_WOUT = 5 * MiB, WS_WUP = 7 * MiB, WS_WDN = 15 * MiB, WS_WPG = 23 * MiB, WS_WPP = 25 * MiB;
constexpr size_t WS_ACTA = 26 * MiB;
constexpr size_t WS_PP = 59 * MiB;
constexpr size_t WS_H = 92 * MiB;
constexpr size_t WS_Z = 92 * MiB;
constexpr size_t WS_MIX = 92 * MiB;
constexpr size_t WS_QC = 167 * MiB;
constexpr size_t WS_CLOC = 184 * MiB;
constexpr size_t WS_CPREV = 200 * MiB;
constexpr size_t WS_PBF = 208 * MiB;
constexpr size_t WS_GATES = 217 * MiB;
constexpr size_t WS_STATS = 218 * MiB;
constexpr size_t WS_D1P = 224 * MiB, WS_D1S = 0;
constexpr size_t WS_CTL = 25 * MiB + 512 * 1024, CTL_BYTES = 81920;
constexpr size_t WS_ATTS = 219 * MiB;
constexpr size_t WS_X2 = WS_ACTA;
constexpr size_t WS_MIXS = 3 * MiB;
constexpr size_t WS_XBUF = 2 * MiB;
constexpr int MISC_OFF = 131072 + 320;
constexpr size_t WS_END = 256 * MiB;
constexpr size_t O_Y = 0, O_CP = 17301504, O_NP = 17367040, O_MP = 17367552, O_CONVP = 17367560, O_KP = 17370632, O_VP = 17403400,
                 O_CS = 17436168, O_NS = 21630472, O_MS = 21663240, O_CONVS = 21663752, O_KS = 21860360, O_VS = 23957512, O_END = 26054664;

__device__ __forceinline__ float bf2f(unsigned short v) { return __uint_as_float(((unsigned)v) << 16); }
__device__ __forceinline__ float bflo(unsigned w) { return __uint_as_float(w << 16); }
__device__ __forceinline__ float bfhi(unsigned w) { return __uint_as_float(w & 0xffff0000u); }
__device__ __forceinline__ unsigned pk2(float lo, float hi) { return pg8::cvt_pk_bf16(lo, hi); }
__device__ __forceinline__ float wave_sum(float v) {
#pragma unroll
    for (int o = 1; o < 64; o <<= 1) v += __shfl_xor(v, o);
    return v;
}
__device__ __forceinline__ float wave_max(float v) {
#pragma unroll
    for (int o = 1; o < 64; o <<= 1) v = fmaxf(v, __shfl_xor(v, o));
    return v;
}
__device__ __forceinline__ float wave_incl_sum(float v, int lane) {
#pragma unroll
    for (int o = 1; o < 64; o <<= 1) { const float n = __shfl_up(v, o); if (lane >= o) v += n; }
    return v;
}
__device__ __forceinline__ float wave_incl_max(float v, int lane) {
#pragma unroll
    for (int o = 1; o < 64; o <<= 1) { const float n = __shfl_up(v, o); if (lane >= o) v = fmaxf(v, n); }
    return v;
}
__device__ __forceinline__ float sigmoidf_(float x) { return 1.f / (1.f + __expf(-x)); }
__device__ __forceinline__ int crow(int r, int hi) { return (r & 3) + 8 * (r >> 2) + 4 * hi; }

struct Args { const float* in[25]; float* out; unsigned char* ws; int ph_lo, ph_hi, coop, pad; };

__device__ __forceinline__ void transpose_item(const float* W, int ldw, int col0, int k0, bf16* WT, int K, int row0, LAS float* scr, int lane) {
    float tv[32];
#pragma unroll
    for (int i = 0; i < 32; ++i) { const int kk = 2 * i + (lane >> 5); tv[i] = W[(size_t)(k0 + kk) * ldw + col0 + (lane & 31)]; }
#pragma unroll
    for (int i = 0; i < 32; ++i) { const int kk = 2 * i + (lane >> 5); scr[kk * 33 + (lane & 31)] = tv[i]; }
    LDS_WAIT(); asm volatile("" ::: "memory");
    const int c = lane & 7;
#pragma unroll
    for (int j = 0; j < 4; ++j) { const int n = (lane >> 3) + 8 * j; const LAS float* s = scr + (8 * c) * 33 + n;
        u32x4 o; o.x = pk2(s[0 * 33], s[1 * 33]); o.y = pk2(s[2 * 33], s[3 * 33]); o.z = pk2(s[4 * 33], s[5 * 33]); o.w = pk2(s[6 * 33], s[7 * 33]);
        *(u32x4*)(WT + (size_t)(row0 + n) * K + k0 + 8 * c) = o; }
    LDS_WAIT(); asm volatile("" ::: "memory");
}

constexpr int I_IN = 16 * 72, I_PP = 4 * 32, I_OUT = 16 * 32, I_UP = 16 * 128, I_DN = 64 * 32, I_PG = 16 * 32;
constexpr int IT_EARLY = I_IN + I_PP, IT_ALL = I_IN + I_PP + I_OUT + I_UP + I_DN + I_PG;
__device__ __forceinline__ void transpose_items(const Args& a, LAS unsigned char* lds, int lo, int hi, int gw, int NGW, int lane, int wave) {
    unsigned char* ws = a.ws;
    LAS float* scr = (LAS float*)(lds + wave * 16384);
    for (int it = lo + gw; it < hi; it += NGW) {
        int r = it;
        if (r < I_IN) { const int kb = r / 72, nb = r % 72; transpose_item(a.in[11], PROJ_W, 32 * nb + (nb >= 48 ? 8 : 0), 64 * kb, (bf16*)(ws + WS_WIN), 1024, 32 * nb, scr, lane); continue; } r -= I_IN;
        if (r < I_PP) { const int kb = r / 32, nb = r % 32; transpose_item(a.in[24], 1024, 32 * nb, 64 * kb, (bf16*)(ws + WS_WPP), 256, 32 * nb, scr, lane); continue; } r -= I_PP;
        if (r < I_OUT) { const int kb = r / 32, nb = r % 32; transpose_item(a.in[17], 1024, 32 * nb, 64 * kb, (bf16*)(ws + WS_WOUT), 1024, 32 * nb, scr, lane); continue; } r -= I_OUT;
        if (r < I_UP) { const int kb = r / 128, nb = r % 128; transpose_item(a.in[20], 4096, 32 * nb, 64 * kb, (bf16*)(ws + WS_WUP), 1024, 32 * nb, scr, lane); continue; } r -= I_UP;
        if (r < I_DN) { const int kb = r / 32, nb = r % 32; transpose_item(a.in[21], 1024, 32 * nb, 64 * kb, (bf16*)(ws + WS_WDN), 4096, 32 * nb, scr, lane); continue; } r -= I_DN;
        { const int kb = r / 32, nb = r % 32; transpose_item(a.in[23], 1024, 32 * nb, 64 * kb, (bf16*)(ws + WS_WPG), 1024, 32 * nb, scr, lane); }
    }
}
__device__ __forceinline__ void p0_prologue(const Args& a, LAS unsigned char* lds, int tid, int lane, int wave) {
    unsigned char* ws = a.ws;
    const int gw = blockIdx.x * NWAVES + wave, NGW = gridDim.x * NWAVES;
    transpose_items(a, lds, 0, IT_EARLY, gw, NGW, lane, wave);
    __syncthreads();
    LAS float* wg = (LAS float*)lds;
    for (int i = tid; i < 8192; i += NTHR) wg[i] = a.in[11][(size_t)(i >> 3) * PROJ_W + 1536 + (i & 7)];
    __syncthreads();
    const float* gpre = a.in[10];
    bf16* XN = (bf16*)(ws + WS_ACTA); bf16* PBF = (bf16*)(ws + WS_PBF); float* GATES = (float*)(ws + WS_GATES);
    f32x4 gq[4];
#pragma unroll
    for (int j = 0; j < 4; ++j) gq[j] = *(const f32x4*)(gpre + 4 * lane + 256 * j);
    f32x4 nv[4], npv;
    { const int m = gw < MT ? gw : 0; const float* xr = m < MP ? a.in[0] + (size_t)m * DM : a.in[1] + (size_t)(m - MP) * DM; const float* pr = m < MP ? a.in[2] + (size_t)m * PD : a.in[3] + (size_t)(m - MP) * PD;
#pragma unroll
      for (int j = 0; j < 4; ++j) nv[j] = *(const f32x4*)(xr + 4 * lane + 256 * j);
      npv = *(const f32x4*)(pr + 4 * lane); }
    for (int m = gw; m < MT; m += NGW) {
        f32x4 v[4]; float s = 0.f;
#pragma unroll
        for (int j = 0; j < 4; ++j) { v[j] = nv[j]; s += (v[j][0] * v[j][0] + v[j][1] * v[j][1]) + (v[j][2] * v[j][2] + v[j][3] * v[j][3]); }
        const f32x4 pv = npv;
        { const int m2 = (m + NGW < MT) ? m + NGW : m; const float* xr = m2 < MP ? a.in[0] + (size_t)m2 * DM : a.in[1] + (size_t)(m2 - MP) * DM; const float* pr = m2 < MP ? a.in[2] + (size_t)m2 * PD : a.in[3] + (size_t)(m2 - MP) * PD;
#pragma unroll
          for (int j = 0; j < 4; ++j) nv[j] = *(const f32x4*)(xr + 4 * lane + 256 * j);
          npv = *(const f32x4*)(pr + 4 * lane); }
        const float rs = 1.f / sqrtf(wave_sum(s) * (1.f / DM) + EPS);
        if (m < MP) {
#pragma unroll
            for (int j = 0; j < 4; ++j) { u32x2 o; o.x = pk2(v[j][0], v[j][1]); o.y = pk2(v[j][2], v[j][3]); *(u32x2*)((bf16*)(ws + WS_D1P) + (size_t)m * DM + 4 * lane + 256 * j) = o; } }
        float ga[8];
#pragma unroll
        for (int q = 0; q < 8; ++q) ga[q] = 0.f;
#pragma unroll
        for (int j = 0; j < 4; ++j) { const f32x4 g = gq[j];
#pragma unroll
            for (int e = 0; e < 4; ++e) { v[j][e] = v[j][e] * rs * g[e]; const LAS f32x4* wp = (const LAS f32x4*)(wg + (4 * lane + 256 * j + e) * 8); const f32x4 w0 = wp[0], w1 = wp[1];
                ga[0] += v[j][e] * w0[0]; ga[1] += v[j][e] * w0[1]; ga[2] += v[j][e] * w0[2]; ga[3] += v[j][e] * w0[3];
                ga[4] += v[j][e] * w1[0]; ga[5] += v[j][e] * w1[1]; ga[6] += v[j][e] * w1[2]; ga[7] += v[j][e] * w1[3]; }
            u32x2 o; o.x = pk2(v[j][0], v[j][1]); o.y = pk2(v[j][2], v[j][3]);
            *(u32x2*)(XN + (size_t)m * DM + 4 * lane + 256 * j) = o; }
        {
            const bool b0 = lane & 1, b1 = lane & 2, b2 = lane & 4;
            float k4[4], k2[2];
#pragma unroll
            for (int q = 0; q < 4; ++q) { const float send = b0 ? ga[q] : ga[q + 4]; const float recv = __shfl_xor(send, 1); k4[q] = (b0 ? ga[q + 4] : ga[q]) + recv; }
#pragma unroll
            for (int q = 0; q < 2; ++q) { const float send = b1 ? k4[q] : k4[q + 2]; const float recv = __shfl_xor(send, 2); k2[q] = (b1 ? k4[q + 2] : k4[q]) + recv; }
            const float send = b2 ? k2[0] : k2[1]; float t = (b2 ? k2[1] : k2[0]) + __shfl_xor(send, 4);
            t += __shfl_xor(t, 8); t += __shfl_xor(t, 16); t += __shfl_xor(t, 32);
            if (lane < 8) GATES[(size_t)m * 8 + 4 * (lane & 1) + (lane & 2) + ((lane >> 2) & 1)] = t; }
        { u32x2 o; o.x = pk2(pv[0], pv[1]); o.y = pk2(pv[2], pv[3]); *(u32x2*)(PBF + (size_t)m * PD + 4 * lane) = o; }
    }
}

__device__ __forceinline__ void chunk_scalars(const float* GATES, const float* bg, int row0, int h, LAS float* SA, LAS float* SB, LAS float* TMP, int tid, int lane, int wave, float& a_out, float& b_out) {
    float s = 0.f, gi = 0.f;
    if (tid < 128) { const float* gp = GATES + (size_t)(row0 + tid) * 8; gi = gp[h] + bg[h]; const float gf = gp[4 + h] + bg[4 + h];
        const float lf = fminf(gf, 0.f) - log1pf(expf(-fabsf(gf))); s = wave_incl_sum(lf, lane); if (lane == 63) TMP[wave] = s; }
    __syncthreads();
    if (tid < 128) { if (wave == 1) s += TMP[0]; SB[tid] = s; SA[tid] = gi - s; }
    a_out = gi - s; b_out = s;
    __syncthreads();
}
template <int NT>
__device__ __forceinline__ void load_vt(const bf16* Z, int row0, int colbase, LAS unsigned* VT32, int t) {
#pragma unroll
    for (int i = 0; i < 1024 / NT; ++i) { const int item = t + NT * i, ch = item & 15, tp = item >> 4;
        const bf16* p0 = Z + (size_t)(row0 + 2 * tp) * NZ + colbase + ch * 8;
        const u32x4 a0 = *(const u32x4*)p0, b0 = *(const u32x4*)(p0 + NZ);
        LAS unsigned* d = VT32 + (ch * 8) * 68 + (((tp >> 2) ^ ch) * 4 + (tp & 3));
#pragma unroll
        for (int e = 0; e < 4; ++e) { d[(2 * e) * 68] = (a0[e] & 0xffffu) | (b0[e] << 16); d[(2 * e + 1) * 68] = (a0[e] >> 16) | (b0[e] & 0xffff0000u); } }
}
__device__ __forceinline__ int vt_off(int row, int oct) { return row * 136 + ((oct ^ ((row >> 3) & 15)) << 3); }

__device__ __forceinline__ void mlstm_b1_unit(const Args& a, LAS unsigned char* lds, int unit, int tid, int lane, int wave) {
    unsigned char* ws = a.ws;
    const bf16* Z = (const bf16*)(ws + WS_Z); bf16* QC = (bf16*)(ws + WS_QC); const float* GATES = (const float*)(ws + WS_GATES);
    float* CLOC = (float*)(ws + WS_CLOC); float* STATS = (float*)(ws + WS_STATS);
    const int bh = unit >> 6, c = unit & 63, b = bh >> 2, h = bh & 3, row0 = b * SEQ + c * 128;
    LAS unsigned* VT32 = (LAS unsigned*)lds; LAS unsigned* KT32 = (LAS unsigned*)(lds + 34816);
    LAS float* SA = (LAS float*)(lds + 52224); LAS float* SB = SA + 128; LAS float* SW = SA + 256; LAS float* TMP = SA + 384;
    float av, bv;
    chunk_scalars(GATES, a.in[12], row0, h, SA, SB, TMP, tid, lane, wave, av, bv);
    if (tid < 128) { const float wm = wave_max(av); if (lane == 0) TMP[4 + wave] = wm; }
    __syncthreads();
    const float amax = fmaxf(TMP[4], TMP[5]), blast = SB[127];
    if (tid < 128) SW[tid] = expf(av - amax);
    if (tid == 0) { STATS[65536 + unit] = blast + amax; STATS[65536 + 512 + unit] = blast; }
    __syncthreads();
    load_vt<NTHR>(Z, row0, ZV + h * 128, VT32, tid);
    {
        const float* cw = a.in[13];
#pragma unroll
        for (int it = 0; it < 2; ++it) {
            const int item = tid + NTHR * it, ch = item & 15, tp = item >> 4; const bool isk = ch >= 8;
            const int cc = (isk ? 256 : 0) + h * 64 + (ch & 7) * 8;
            const int t0 = 2 * tp; const float w0s = SW[t0], w1s = SW[t0 + 1];
            float r[5][8];
#pragma unroll
            for (int j = 0; j < 5; ++j) { const int tt = c * 128 + t0 - 3 + j;
                if (tt >= 0) { const u32x4 w = *(const u32x4*)(Z + (size_t)(row0 + t0 - 3 + j) * NZ + cc);
#pragma unroll
                    for (int e = 0; e < 4; ++e) { r[j][2 * e] = bflo(w[e]); r[j][2 * e + 1] = bfhi(w[e]); } }
                else {
#pragma unroll
                    for (int e = 0; e < 8; ++e) r[j][e] = 0.f; } }
            float o0[8], o1[8];
#pragma unroll
            for (int e = 0; e < 8; ++e) { const float c0 = cw[cc + e], c1 = cw[512 + cc + e], c2 = cw[1024 + cc + e], c3 = cw[1536 + cc + e];
                float x0 = c0 * r[0][e] + c1 * r[1][e] + c2 * r[2][e] + c3 * r[3][e]; float x1 = c0 * r[1][e] + c1 * r[2][e] + c2 * r[3][e] + c3 * r[4][e];
                x0 = x0 * sigmoidf_(x0); x1 = x1 * sigmoidf_(x1);
                if (!isk) { x0 *= 0.125f; x1 *= 0.125f; }
                o0[e] = x0; o1[e] = x1; }
            u32x4 s0, s1;
#pragma unroll
            for (int e = 0; e < 4; ++e) { s0[e] = pk2(o0[2 * e], o0[2 * e + 1]); s1[e] = pk2(o1[2 * e], o1[2 * e + 1]); }
            *(u32x4*)(QC + (size_t)(row0 + t0) * 512 + cc) = s0; *(u32x4*)(QC + (size_t)(row0 + t0 + 1) * 512 + cc) = s1;
            if (isk) { const int g = ch & 7; LAS unsigned* d = KT32 + (g * 8) * 68 + (((tp >> 2) ^ g) * 4 + (tp & 3));
#pragma unroll
                for (int e = 0; e < 8; ++e) d[e * 68] = pk2(o0[e] * w0s, o1[e] * w1s); }
        }
    }
    __syncthreads();
    {
        const int vt = wave >> 1, dt = wave & 1, l32 = lane & 31, hi = lane >> 5;
        const LAS bf16* VT = (const LAS bf16*)VT32; const LAS bf16* KT = (const LAS bf16*)KT32;
        f32x16 acc = {};
#pragma unroll
        for (int s0 = 0; s0 < 128; s0 += 16) {
            const int oct = (s0 >> 3) + hi, rv = vt * 32 + l32, rk = dt * 32 + l32;
            const bf16x8 A = *(const LAS bf16x8*)(VT + vt_off(rv, oct));
            const bf16x8 B = *(const LAS bf16x8*)(KT + rk * 136 + ((oct ^ ((rk >> 3) & 7)) << 3));
            acc = __builtin_amdgcn_mfma_f32_32x32x16_bf16(A, B, acc, 0, 0, 0); }
        float* cp = CLOC + (size_t)unit * 8192 + dt * 32 + l32;
#pragma unroll
        for (int r = 0; r < 16; ++r) cp[(vt * 32 + crow(r, hi)) * 64] = acc[r];
        if (tid < 64) { float s = 0.f;
#pragma unroll
            for (int q = 0; q < 16; ++q) { const u32x4 w = *(const LAS u32x4*)(KT + tid * 136 + 8 * q);
#pragma unroll
                for (int e = 0; e < 4; ++e) s += bflo(w[e]) + bfhi(w[e]); }
            STATS[unit * 64 + tid] = s; }
    }
    __syncthreads();
}

__device__ __forceinline__ void mlstm_scan(const Args& a, int tid) {
    unsigned char* ws = a.ws;
    const float* CLOC = (const float*)(ws + WS_CLOC); bf16* CPREV = (bf16*)(ws + WS_CPREV); float* STATS = (float*)(ws + WS_STATS);
    const float* NLOC = STATS; float* NPREV = STATS + 32768; const float* MLOC = STATS + 65536; const float* BLAST = STATS + 65536 + 512; float* MPREV = STATS + 65536 + 1024;
    const int j = blockIdx.x;
    if (j < 128) {
        const int e = j * 512 + tid, bh = e >> 13, idx = e & 8191;
        float C = 0.f, m = 0.f;
        {
            constexpr int c0 = 0;
            float cl[64];
#pragma unroll
            for (int i = 0; i < 64; ++i) cl[i] = CLOC[(size_t)(bh * 64 + i) * 8192 + idx];
#pragma unroll
            for (int i = 0; i < 64; ++i) { const int u = bh * 64 + c0 + i; const float bl = BLAST[u], ml = MLOC[u];
                CPREV[(size_t)u * 8192 + idx] = (bf16)(pk2(C, 0.f) & 0xffffu);
                const float mn = fmaxf(bl + m, ml); C = expf(bl + m - mn) * C + expf(ml - mn) * cl[i]; m = mn; }
        }
        const int v = idx >> 6, d = idx & 63;
        a.out[O_CP + (size_t)bh * 8192 + d * 128 + v] = C;
    } else if (j == 128) {
        const int bh = tid >> 6, d = tid & 63;
        float n = 0.f, m = 0.f;
        for (int c0 = 0; c0 < 64; c0 += 16) {
            float nl[16], bl[16], ml[16];
#pragma unroll
            for (int i = 0; i < 16; ++i) { const int u = bh * 64 + c0 + i; nl[i] = NLOC[u * 64 + d]; bl[i] = BLAST[u]; ml[i] = MLOC[u]; }
#pragma unroll
            for (int i = 0; i < 16; ++i) { const int u = bh * 64 + c0 + i;
                NPREV[u * 64 + d] = n; if (d == 0) MPREV[u] = m;
                const float mn = fmaxf(bl[i] + m, ml[i]); n = expf(bl[i] + m - mn) * n + expf(ml[i] - mn) * nl[i]; m = mn; } }
        a.out[O_NP + bh * 64 + d] = n; if (d == 0) a.out[O_MP + bh] = m;
    }
}

__device__ __forceinline__ void mlstm_b3_pair(const Args& a, LAS unsigned char* lds0, int u0, int tid, int lane, int wave) {
    unsigned char* ws = a.ws;
    const bf16* Z = (const bf16*)(ws + WS_Z); const bf16* QC = (const bf16*)(ws + WS_QC); const float* GATES = (const float*)(ws + WS_GATES);
    const bf16* CPREV = (const bf16*)(ws + WS_CPREV); const float* STATS = (const float*)(ws + WS_STATS); bf16* YMIX = (bf16*)(ws + WS_ACTA);
    const int half = wave >> 2, lw = wave & 3, lt = tid & 255, unit = u0 + half;
    LAS unsigned char* lds = lds0 + half * 57344;
    const int bh = unit >> 6, c = unit & 63, b = bh >> 2, h = bh & 3, row0 = b * SEQ + c * 128;
    LAS unsigned* VT32 = (LAS unsigned*)lds; LAS bf16* KL = (LAS bf16*)(lds + 34816);
    LAS float* SA = (LAS float*)(lds + 53248); LAS float* SB = SA + 128; LAS float* SM = SA + 256; LAS float* TMP = SA + 384; LAS float* NP = SA + 400; LAS float* GM = SA + 464;
    const int tb = lw, l32 = lane & 31, hi = lane >> 5, t = tb * 32 + l32;
    const size_t rowt = (size_t)(row0 + t);
    bf16x8 qf[4];
#pragma unroll
    for (int d0 = 0; d0 < 4; ++d0) qf[d0] = *(const bf16x8*)(QC + rowt * 512 + h * 64 + d0 * 16 + 8 * hi);
    bf16x8 cf[4][4];
#pragma unroll
    for (int vt = 0; vt < 4; ++vt)
#pragma unroll
        for (int d0 = 0; d0 < 4; ++d0) cf[vt][d0] = *(const bf16x8*)(CPREV + ((size_t)unit * 128 + vt * 32 + l32) * 64 + d0 * 16 + 8 * hi);
    {
#pragma unroll
      for (int i = 0; i < 4; ++i) { const int idx = lt + 256 * i, s = idx >> 3, ch = idx & 7;
          *(LAS u32x4*)(KL + s * 72 + ch * 8) = *(const u32x4*)(QC + (size_t)(row0 + s) * 512 + 256 + h * 64 + ch * 8); } }
    const float mprev = STATS[65536 + 1024 + unit];
    float s = 0.f, gi = 0.f, pm = 0.f;
    if (lt < 128) { const float* gp = GATES + (size_t)(row0 + lt) * 8; gi = gp[h] + a.in[12][h]; const float gf = gp[4 + h] + a.in[12][4 + h];
        const float lf = fminf(gf, 0.f) - log1pf(expf(-fabsf(gf))); s = wave_incl_sum(lf, lane); if (lane == 63) TMP[lw] = s; }
    if (lt >= 128 && lt < 192) NP[lt - 128] = STATS[32768 + unit * 64 + (lt - 128)];
    if (lt >= 192) { GM[lt - 192] = a.in[14][h * 128 + lt - 192]; GM[lt - 128] = a.in[14][h * 128 + lt - 128]; }
    load_vt<256>(Z, row0, ZV + h * 128, VT32, lt);
    __syncthreads();
    float av = 0.f;
    if (lt < 128) { if (lw == 1) s += TMP[0]; SB[lt] = s; av = gi - s; SA[lt] = av; pm = wave_incl_max(av, lane); if (lane == 63) TMP[4 + lw] = pm; }
    __syncthreads();
    if (lt < 128) { if (lw == 1) pm = fmaxf(pm, TMP[4]); SM[lt] = fmaxf(mprev, pm); }
    __syncthreads();
    const float L2E = 1.4426950408889634f;
    const float Mt = SM[t], winter = __builtin_amdgcn_exp2f((mprev - Mt) * L2E);
    f32x16 acc[4];
#pragma unroll
    for (int vt = 0; vt < 4; ++vt) { acc[vt] = (f32x16){};
#pragma unroll
        for (int d0 = 0; d0 < 4; ++d0) acc[vt] = __builtin_amdgcn_mfma_f32_32x32x16_bf16(cf[vt][d0], qf[d0], acc[vt], 0, 0, 0);
#pragma unroll
        for (int r = 0; r < 16; ++r) acc[vt][r] *= winter; }
    float den = 0.f;
    const LAS bf16* VT = (const LAS bf16*)VT32;
    for (int st = 0; st <= tb; ++st) {
        f32x16 S = {};
#pragma unroll
        for (int d0 = 0; d0 < 4; ++d0) { const bf16x8 A = *(const LAS bf16x8*)(KL + (st * 32 + l32) * 72 + d0 * 16 + 8 * hi);
            S = __builtin_amdgcn_mfma_f32_32x32x16_bf16(A, qf[d0], S, 0, 0, 0); }
        float p[16];
#pragma unroll
        for (int r = 0; r < 16; ++r) { const int sl = crow(r, hi); const float w = __builtin_amdgcn_exp2f((SA[st * 32 + sl] - Mt) * L2E); float pv = S[r] * w; if (st == tb && sl > l32) pv = 0.f; p[r] = pv; den += pv; }
        u32x4 pb0, pb1;
#pragma unroll
        for (int e = 0; e < 4; ++e) { pb0[e] = pk2(p[2 * e], p[2 * e + 1]); pb1[e] = pk2(p[8 + 2 * e], p[8 + 2 * e + 1]); }
#pragma unroll
        for (int vt = 0; vt < 4; ++vt) { const int rv = vt * 32 + l32;
            const u32x2 x0 = *(const LAS u32x2*)(VT + vt_off(rv, st * 4 + 0) + 4 * hi), x1 = *(const LAS u32x2*)(VT + vt_off(rv, st * 4 + 1) + 4 * hi), x2 = *(const LAS u32x2*)(VT + vt_off(rv, st * 4 + 2) + 4 * hi), x3 = *(const LAS u32x2*)(VT + vt_off(rv, st * 4 + 3) + 4 * hi);
            const u32x4 A0 = {x0.x, x0.y, x1.x, x1.y}, A1 = {x2.x, x2.y, x3.x, x3.y};
            acc[vt] = __builtin_amdgcn_mfma_f32_32x32x16_bf16(__builtin_bit_cast(bf16x8, A0), __builtin_bit_cast(bf16x8, pb0), acc[vt], 0, 0, 0);
            acc[vt] = __builtin_amdgcn_mfma_f32_32x32x16_bf16(__builtin_bit_cast(bf16x8, A1), __builtin_bit_cast(bf16x8, pb1), acc[vt], 0, 0, 0); }
    }
    den += __shfl_xor(den, 32);
    float qn = 0.f;
#pragma unroll
    for (int d0 = 0; d0 < 4; ++d0)
#pragma unroll
        for (int e = 0; e < 8; ++e) qn += bf2f((unsigned short)qf[d0][e]) * NP[d0 * 16 + 8 * hi + e];
    qn += __shfl_xor(qn, 32);
    den += winter * qn;
    const float mt = SB[t] + Mt;
    const float inv = 1.f / fmaxf(fabsf(den), __builtin_amdgcn_exp2f(-mt * L2E));
    float ss = 0.f;
#pragma unroll
    for (int vt = 0; vt < 4; ++vt)
#pragma unroll
        for (int r = 0; r < 16; ++r) { acc[vt][r] *= inv; ss += acc[vt][r] * acc[vt][r]; }
    ss += __shfl_xor(ss, 32);
    const float rn = 1.f / sqrtf(ss * (1.f / 128.f) + EPS);
    u32x4 ogr[8];
#pragma unroll
    for (int i = 0; i < 8; ++i) { const int rr = 4 * i + (lane >> 4), ch = lane & 15; ogr[i] = *(const u32x4*)(Z + (size_t)(row0 + tb * 32 + rr) * NZ + ZO + h * 128 + ch * 8); }
    __syncthreads();
    LAS bf16* STG = (LAS bf16*)lds + lw * 4352;
#pragma unroll
    for (int vt = 0; vt < 4; ++vt) {
        f32x4 g4[4];
#pragma unroll
        for (int rg = 0; rg < 4; ++rg) g4[rg] = *(const LAS f32x4*)(GM + vt * 32 + 8 * rg + 4 * hi);
#pragma unroll
        for (int rg = 0; rg < 4; ++rg) { const int v = vt * 32 + 8 * rg + 4 * hi;
            u32x2 o; o.x = pk2(acc[vt][4 * rg] * rn * g4[rg][0], acc[vt][4 * rg + 1] * rn * g4[rg][1]); o.y = pk2(acc[vt][4 * rg + 2] * rn * g4[rg][2], acc[vt][4 * rg + 3] * rn * g4[rg][3]);
            *(LAS u32x2*)(STG + l32 * 136 + v) = o; } }
    LDS_WAIT(); asm volatile("" ::: "memory");
#pragma unroll
    for (int i = 0; i < 8; ++i) { const int rr = 4 * i + (lane >> 4), ch = lane & 15; const u32x4 hw = *(const LAS u32x4*)(STG + rr * 136 + ch * 8); const u32x4 ow = ogr[i];
        u32x4 y;
#pragma unroll
        for (int e = 0; e < 4; ++e) y[e] = pk2(sigmoidf_(bflo(ow[e])) * bflo(hw[e]), sigmoidf_(bfhi(ow[e])) * bfhi(hw[e]));
        *(u32x4*)(YMIX + (size_t)(row0 + tb * 32 + rr) * DM + h * 128 + ch * 8) = y; }
    __syncthreads();
}
#define XB_TMO      128
#define XB_XCNT(j)  (256  + 64 * (j))
#define XB_XSUB(j)  (1280 + 64 * (j))
#define XB_XGEN(j)  (2304 + 64 * (j))
#define XB_TOP      3328
#define XB_TOPGEN   3392
#define XCD_BAR_WORDS 3456
#define XB_SPIN_CAP (1u << 18)

__device__ __forceinline__ unsigned xb_ld(unsigned* p)              { return __hip_atomic_load(p, __ATOMIC_RELAXED, __HIP_MEMORY_SCOPE_AGENT); }
__device__ __forceinline__ unsigned xb_add(unsigned* p, unsigned v) { return __hip_atomic_fetch_add(p, v, __ATOMIC_RELAXED, __HIP_MEMORY_SCOPE_AGENT); }
__device__ __forceinline__ unsigned xb_xcc_id() { return (unsigned)__builtin_amdgcn_s_getreg((3 << 11) | 20) & 0xFu; }
#define XB_SPIN(cond, bar) do { unsigned _sp = 0; while (cond) { __builtin_amdgcn_s_sleep(1); \
    if ((++_sp & 255u) == 0u) { if (xb_ld(&(bar)[XB_TMO])) break; if (_sp > XB_SPIN_CAP) { atomicAdd(&(bar)[XB_TMO], 1u); break; } } } } while (0)

struct XcdBarrier {
    unsigned* bar; unsigned x;
    volatile LAS unsigned* st;
};

__device__ __forceinline__ XcdBarrier xcd_barrier_post(unsigned* bar, volatile LAS unsigned* st) {
    XcdBarrier b; b.bar = bar; b.x = xb_xcc_id(); b.st = st;
    if (threadIdx.x == 0) (void)xb_add(&bar[XB_XCNT(b.x)], 1u);
    return b;
}
__device__ __forceinline__ void xcd_barrier_complete(unsigned* bar, unsigned x, unsigned& nloc, unsigned& nx) {
    const unsigned G = gridDim.x * gridDim.y * gridDim.z;
    unsigned sum, cnt, mine, sp = 0u;
    for (;;) {
        sum = 0u; cnt = 0u; mine = 0u;
#pragma unroll
        for (unsigned j = 0; j < 16; ++j) { const unsigned c = xb_ld(&bar[XB_XCNT(j)]); sum += c; cnt += (c > 0u) ? 1u : 0u; mine = (j == x) ? c : mine; }
        if (sum == G) break;
        __builtin_amdgcn_s_sleep(1);
        if ((++sp & 255u) == 0u) { if (xb_ld(&bar[XB_TMO])) break; if (sp > XB_SPIN_CAP) { atomicAdd(&bar[XB_TMO], 1u); break; } }
    }
    nloc = mine > 0u ? mine : 1u; nx = cnt > 0u ? cnt : 1u;
}

__device__ __forceinline__ void xcd_barrier(const XcdBarrier& b) {
    asm volatile("s_waitcnt vmcnt(0)" ::: "memory");
    __syncthreads();
    if (threadIdx.x == 0) {
        unsigned* bar = b.bar;
        __builtin_amdgcn_s_waitcnt(0);
        unsigned nloc = b.st[0], nx = b.st[1];
        if (nloc == 0u) { xcd_barrier_complete(bar, b.x, nloc, nx); b.st[0] = nloc; b.st[1] = nx; }
        const unsigned old = xb_add(&bar[XB_XSUB(b.x)], 1u);
        const unsigned gen = old / nloc;
        if (old + 1u == (gen + 1u) * nloc) {
            __builtin_amdgcn_fence(__ATOMIC_RELEASE, "agent");
            asm volatile("s_waitcnt vmcnt(0)" ::: "memory");
            const unsigned og = xb_add(&bar[XB_TOP], 1u);
            const unsigned tg = og / nx;
            if (og + 1u == (tg + 1u) * nx) xb_add(&bar[XB_TOPGEN], 1u);
            else XB_SPIN(xb_ld(&bar[XB_TOPGEN]) == tg, bar);
            __builtin_amdgcn_fence(__ATOMIC_ACQUIRE, "agent");
            xb_add(&bar[XB_XGEN(b.x)], 1u);
            asm volatile("s_waitcnt vmcnt(0)" ::: "memory");
        } else {
            XB_SPIN(xb_ld(&bar[XB_XGEN(b.x)]) == gen, bar);
            __builtin_amdgcn_fence(__ATOMIC_ACQUIRE, "agent");
            asm volatile("s_waitcnt vmcnt(0)" ::: "memory");
        }
    }
    __syncthreads();
}
__device__ __forceinline__ void swa_prompt_unit(const Args& a, LAS unsigned char* lds, int unit, int tid, int lane, int wave) {
    unsigned char* ws = a.ws;
    const bf16* Z = (const bf16*)(ws + WS_Z); bf16* YMIX = (bf16*)(ws + WS_ACTA);
    const int half = unit & 1, n = (unit >> 1) & 63, b = unit >> 7;
    LAS bf16* KL = (LAS bf16*)lds; LAS unsigned* VT32 = (LAS unsigned*)(lds + 55296); LAS float* SSP = (LAS float*)(lds + 106496);
    const int tok0 = n * 128 - 128 + half * 64;
    const int hq = wave, kv = hq >> 2, l32 = lane & 31, hi = lane >> 5;
    bf16x8 qf[2][4];
#pragma unroll
    for (int qb = 0; qb < 2; ++qb) { const size_t row_ = (size_t)(b * SEQ + n * 128 + half * 64 + qb * 32 + l32);
#pragma unroll
        for (int d0 = 0; d0 < 4; ++d0) qf[qb][d0] = *(const bf16x8*)(Z + row_ * NZ + ZQA + hq * 64 + d0 * 16 + 8 * hi); }
#pragma unroll
    for (int i = 0; i < 6; ++i) { const int idx = tid + NTHR * i, ch = idx & 7, rk = idx >> 3, kvv = rk / 192, lk = rk % 192, tok = tok0 + lk;
        u32x4 w = {0u, 0u, 0u, 0u}; if (tok >= 0) w = *(const u32x4*)(Z + (size_t)(b * SEQ + tok) * NZ + ZKA + kvv * 64 + ch * 8);
        *(LAS u32x4*)(KL + (kvv * 192 + lk) * 72 + ch * 8) = w; }
#pragma unroll
    for (int i = 0; i < 3; ++i) { const int idx = tid + NTHR * i, ch = idx & 7, rest = idx >> 3, kvv = rest / 96, kp = rest % 96, tok = tok0 + 2 * kp;
        u32x4 a0 = {0u, 0u, 0u, 0u}, b0 = {0u, 0u, 0u, 0u};
        if (tok >= 0) { const bf16* p = Z + (size_t)(b * SEQ + tok) * NZ + ZVA + kvv * 64 + ch * 8; a0 = *(const u32x4*)p; b0 = *(const u32x4*)(p + NZ); }
        LAS unsigned* d = VT32 + (kvv * 64 + ch * 8) * 100 + kp;
#pragma unroll
        for (int e = 0; e < 4; ++e) { d[(2 * e) * 100] = (a0[e] & 0xffffu) | (b0[e] << 16); d[(2 * e + 1) * 100] = (a0[e] >> 16) | (b0[e] & 0xffff0000u); } }
    __syncthreads();
    const float slope = exp2f(-(float)(hq + 1)), L2E = 1.4426950408889634f, sink2 = a.in[15][hq] * L2E;
    const LAS bf16* VT = (const LAS bf16*)VT32;
    f32x16 O[2][2];
#pragma unroll
    for (int qb = 0; qb < 2; ++qb) {
        float mrun = sink2, ls = 0.f;
        O[qb][0] = (f32x16){}; O[qb][1] = (f32x16){};
#pragma unroll 1
        for (int j = 0; j < 5; ++j) {
            f32x16 S = {};
#pragma unroll
            for (int d0 = 0; d0 < 4; ++d0) { const bf16x8 A = *(const LAS bf16x8*)(KL + (kv * 192 + qb * 32 + 32 * j + l32) * 72 + d0 * 16 + 8 * hi);
                S = __builtin_amdgcn_mfma_f32_32x32x16_bf16(A, qf[qb][d0], S, 0, 0, 0); }
            float mx = mrun;
#pragma unroll
            for (int r = 0; r < 16; ++r) { const int lk = qb * 32 + 32 * j + crow(r, hi); const int dist = 128 + l32 - 32 * j - crow(r, hi);
                const bool valid = dist >= 0 && dist <= 128 && (n > 0 || half * 64 + lk >= 128);
                const float sc = valid ? (S[r] * 0.125f - slope * (float)dist) * L2E : -INFINITY; S[r] = sc; mx = fmaxf(mx, sc); }
            mx = fmaxf(mx, __shfl_xor(mx, 32));
            const float alpha = __builtin_amdgcn_exp2f(mrun - mx); mrun = mx;
            float lt = 0.f;
#pragma unroll
            for (int r = 0; r < 16; ++r) { const float e = __builtin_amdgcn_exp2f(S[r] - mx); S[r] = e; lt += e; }
            ls = ls * alpha + lt;
            u32x4 pb0, pb1;
#pragma unroll
            for (int e = 0; e < 4; ++e) { pb0[e] = pk2(S[2 * e], S[2 * e + 1]); pb1[e] = pk2(S[8 + 2 * e], S[8 + 2 * e + 1]); }
#pragma unroll
            for (int dt = 0; dt < 2; ++dt) { const LAS bf16* vp = VT + (kv * 64 + dt * 32 + l32) * 200 + qb * 32 + 32 * j + 4 * hi;
                const u32x2 x0 = *(const LAS u32x2*)vp, x1 = *(const LAS u32x2*)(vp + 8), x2 = *(const LAS u32x2*)(vp + 16), x3 = *(const LAS u32x2*)(vp + 24);
                const u32x4 A0 = {x0.x, x0.y, x1.x, x1.y}, A1 = {x2.x, x2.y, x3.x, x3.y};
#pragma unroll
                for (int r = 0; r < 16; ++r) O[qb][dt][r] *= alpha;
                O[qb][dt] = __builtin_amdgcn_mfma_f32_32x32x16_bf16(__builtin_bit_cast(bf16x8, A0), __builtin_bit_cast(bf16x8, pb0), O[qb][dt], 0, 0, 0);
                O[qb][dt] = __builtin_amdgcn_mfma_f32_32x32x16_bf16(__builtin_bit_cast(bf16x8, A1), __builtin_bit_cast(bf16x8, pb1), O[qb][dt], 0, 0, 0); } }
        ls += __shfl_xor(ls, 32); ls += __builtin_amdgcn_exp2f(sink2 - mrun);
        const float il = 1.f / ls; float ss = 0.f;
#pragma unroll
        for (int dt = 0; dt < 2; ++dt)
#pragma unroll
            for (int r = 0; r < 16; ++r) { O[qb][dt][r] *= il; ss += O[qb][dt][r] * O[qb][dt][r]; }
        ss += __shfl_xor(ss, 32);
        if (hi == 0) SSP[hq * 64 + qb * 32 + l32] = ss;
    }
    __syncthreads();
    const float* ga = a.in[16];
#pragma unroll
    for (int qb = 0; qb < 2; ++qb) {
        float tot = 0.f;
#pragma unroll
        for (int q = 0; q < 8; ++q) tot += SSP[q * 64 + qb * 32 + l32];
        const float rn = 1.f / sqrtf(tot * (1.f / 512.f) + EPS);
        const size_t row = (size_t)(b * SEQ + n * 128 + half * 64 + qb * 32 + l32);
#pragma unroll
        for (int dt = 0; dt < 2; ++dt)
#pragma unroll
            for (int rg = 0; rg < 4; ++rg) { const int col = hq * 64 + dt * 32 + 8 * rg + 4 * hi; const f32x4 g4 = *(const f32x4*)(ga + col);
                u32x2 o; o.x = pk2(O[qb][dt][4 * rg] * rn * g4[0], O[qb][dt][4 * rg + 1] * rn * g4[1]); o.y = pk2(O[qb][dt][4 * rg + 2] * rn * g4[2], O[qb][dt][4 * rg + 3] * rn * g4[3]);
                *(u32x2*)(YMIX + row * DM + 512 + col) = o; }
    }
    __syncthreads();
}

__device__ __forceinline__ void mlstm_sample_prefetch(const Args& a, int unit, int tid, float (&cs)[16]) {
    const int dg = tid >> 7, v = tid & 127; const float* C0 = a.in[4] + (size_t)unit * 8192;
#pragma unroll
    for (int dd = 0; dd < 16; ++dd) cs[dd] = C0[(dg * 16 + dd) * 128 + v];
}
__device__ __forceinline__ void mlstm_sample_unit(const Args& a, LAS unsigned char* lds, int unit, int tid, int lane, int wave, const float (&cs)[16]) {
    unsigned char* ws = a.ws;
    const bf16* Z = (const bf16*)(ws + WS_Z); const float* GATES = (const float*)(ws + WS_GATES); bf16* YMIX = (bf16*)(ws + WS_ACTA);
    const int b = unit >> 2, h = unit & 3; const int rowb = MP + b * 4;
    LAS float* QS = (LAS float*)lds; LAS float* KS = QS + 256; LAS float* VS = QS + 512; LAS float* SR = QS + 1024; LAS float* QN = QS + 1040; LAS float* RED = QS + 1048; LAS float* PART = QS + 1056;
    const float* bg = a.in[12];
    const float m0 = a.in[6][unit];
    float ig[4], bc[4], av[4], Mt[4]; float run = 0.f, pm = -INFINITY;
#pragma unroll
    for (int t = 0; t < 4; ++t) { const float* gp = GATES + (size_t)(rowb + t) * 8; ig[t] = gp[h] + bg[h]; const float gf = gp[4 + h] + bg[4 + h];
        run += fminf(gf, 0.f) - log1pf(expf(-fabsf(gf))); bc[t] = run; av[t] = ig[t] - run; pm = fmaxf(pm, av[t]); Mt[t] = fmaxf(m0, pm); }
    const float blast = bc[3], mnew = fmaxf(blast + m0, blast + pm), decay = expf(blast + m0 - mnew);
    float wk[4];
#pragma unroll
    for (int s = 0; s < 4; ++s) wk[s] = expf(blast + av[s] - mnew);
    {
        const int t = tid >> 7, cl = tid & 127; const int col = cl < 64 ? h * 64 + cl : 256 + h * 64 + (cl - 64);
        const float* cb = a.in[7] + (size_t)b * 3 * 512; const float* cw = a.in[13];
        float x = 0.f, raw = 0.f;
#pragma unroll
        for (int j = 0; j < 4; ++j) { const int i = t + j; const float u = i < 3 ? cb[i * 512 + col] : bf2f(Z[(size_t)(rowb + i - 3) * NZ + ZQK + col]); x += cw[j * 512 + col] * u; if (j == 3) raw = u; }
        x = x * sigmoidf_(x);
        if (cl < 64) QS[t * 64 + cl] = x * 0.125f; else KS[t * 64 + cl - 64] = x;
        if (t >= 1) a.out[O_CONVS + ((size_t)b * 3 + (t - 1)) * 512 + col] = raw;
        VS[t * 128 + cl] = bf2f(Z[(size_t)(rowb + t) * NZ + ZV + h * 128 + cl]);
    }
    __syncthreads();
    if (tid < 16) { const int t = tid >> 2, s = tid & 3; float d = 0.f;
#pragma unroll 8
        for (int e = 0; e < 64; ++e) d += QS[t * 64 + e] * KS[s * 64 + e];
        SR[tid] = d; }
    else if (tid < 20) { const int t = tid - 16; const float* n0 = a.in[5] + (size_t)unit * 64; float d = 0.f;
#pragma unroll 8
        for (int e = 0; e < 64; ++e) d += QS[t * 64 + e] * n0[e];
        QN[t] = d; }
    else if (tid >= 64 && tid < 128) { const int d = tid - 64; float nn = decay * a.in[5][(size_t)unit * 64 + d];
#pragma unroll
        for (int s = 0; s < 4; ++s) nn += wk[s] * KS[s * 64 + d];
        a.out[O_NS + (size_t)unit * 64 + d] = nn; }
    if (tid == 0) a.out[O_MS + unit] = mnew;
    {
        const int dg = tid >> 7, v = tid & 127;
        float* CN = a.out + O_CS + (size_t)unit * 8192;
        float vv[4], part[4] = {0.f, 0.f, 0.f, 0.f};
#pragma unroll
        for (int s = 0; s < 4; ++s) vv[s] = VS[s * 128 + v] * wk[s];
#pragma unroll
        for (int dd = 0; dd < 16; ++dd) { const int d = dg * 16 + dd; const float c = cs[dd]; float cn = decay * c;
#pragma unroll
            for (int s = 0; s < 4; ++s) { part[s] += QS[s * 64 + d] * c; cn += KS[s * 64 + d] * vv[s]; }
            CN[d * 128 + v] = cn; }
#pragma unroll
        for (int t = 0; t < 4; ++t) PART[(dg * 4 + t) * 128 + v] = part[t];
    }
    __syncthreads();
    {
        const int t = tid >> 7, v = tid & 127;
        const float Mtt = t == 0 ? Mt[0] : t == 1 ? Mt[1] : t == 2 ? Mt[2] : Mt[3];
        const float bct = t == 0 ? bc[0] : t == 1 ? bc[1] : t == 2 ? bc[2] : bc[3];
        const float winter = expf(m0 - Mtt);
        const float qC = PART[(0 * 4 + t) * 128 + v] + PART[(1 * 4 + t) * 128 + v] + PART[(2 * 4 + t) * 128 + v] + PART[(3 * 4 + t) * 128 + v];
        float num = winter * qC, den = winter * QN[t];
#pragma unroll
        for (int s = 0; s < 4; ++s) { const float w = (s <= t) ? SR[t * 4 + s] * expf(av[s] - Mtt) : 0.f; num += w * VS[s * 128 + v]; den += w; }
        const float hv = num / fmaxf(fabsf(den), expf(-(bct + Mtt)));
        const float ssw = wave_sum(hv * hv);
        if (lane == 0) RED[wave] = ssw;
        __syncthreads();
        const float tot = RED[2 * t] + RED[2 * t + 1];
        const float y = hv / sqrtf(tot * (1.f / 128.f) + EPS) * a.in[14][h * 128 + v] * sigmoidf_(bf2f(Z[(size_t)(rowb + t) * NZ + ZO + h * 128 + v]));
        YMIX[(size_t)(rowb + t) * DM + h * 128 + v] = (bf16)(pk2(y, 0.f) & 0xffffu);
    }
    __syncthreads();
}

__device__ __forceinline__ void swa_sample_prefetch(const Args& a, int unit, int tid, f32x4 (&kq)[4], f32x4 (&vq)[4]) {
    const int b = unit >> 1, kv = unit & 1;
#pragma unroll
    for (int i = 0; i < 4; ++i) { const int ch = tid + NTHR * i, j = ch >> 4, d4 = (ch & 15) * 4; const size_t o = (((size_t)b * 128 + j) * 2 + kv) * 64 + d4; kq[i] = *(const f32x4*)(a.in[8] + o); vq[i] = *(const f32x4*)(a.in[9] + o); }
}
__device__ __forceinline__ void swa_sample_unit(const Args& a, LAS unsigned char* lds, int unit, int tid, int lane, int wave, const f32x4 (&kq)[4], const f32x4 (&vq)[4]) {
    unsigned char* ws = a.ws;
    const bf16* Z = (const bf16*)(ws + WS_Z); float* ATTS = (float*)(ws + WS_ATTS);
    LAS float* KA = (LAS float*)lds; LAS float* VA = KA + 132 * 65; LAS float* QS = VA + 132 * 65; LAS float* SC = QS + 16 * 65;
    const int b = unit >> 1, kv = unit & 1, rowb = MP + b * 4;
    {
#pragma unroll
        for (int i = 0; i < 4; ++i) { const int ch = tid + NTHR * i, j = ch >> 4, d4 = (ch & 15) * 4;
#pragma unroll
            for (int e = 0; e < 4; ++e) { KA[j * 65 + d4 + e] = kq[i][e]; VA[j * 65 + d4 + e] = vq[i][e]; }
            if (j >= 4) { const size_t o = (((size_t)b * 128 + (j - 4)) * 2 + kv) * 64 + d4; *(f32x4*)(a.out + O_KS + o) = kq[i]; *(f32x4*)(a.out + O_VS + o) = vq[i]; } }
        if (tid < 256) { const int j = 128 + (tid >> 6), d = tid & 63; const size_t zo = (size_t)(rowb + j - 128) * NZ + kv * 64 + d; const float kk = bf2f(Z[zo + ZKA]), vv = bf2f(Z[zo + ZVA]);
            KA[j * 65 + d] = kk; VA[j * 65 + d] = vv; const size_t o = (((size_t)b * 128 + (j - 4)) * 2 + kv) * 64 + d; a.out[O_KS + o] = kk; a.out[O_VS + o] = vv; }
#pragma unroll
        for (int i = 0; i < 2; ++i) { const int idx = tid + NTHR * i, r = idx >> 6, d = idx & 63, g = r >> 2, t = r & 3;
            QS[r * 65 + d] = bf2f(Z[(size_t)(rowb + t) * NZ + ZQA + (kv * 4 + g) * 64 + d]); }
    }
    __syncthreads();
    { const int r = tid & 15, kk = tid >> 4, g = r >> 2, i = r & 3; const float slope = exp2f(-(float)(kv * 4 + g + 1));
#pragma unroll
      for (int jj = 0; jj < 5; ++jj) { const int key = kk + 32 * jj;
          if (key < 132) { float d = 0.f;
#pragma unroll 16
              for (int e = 0; e < 64; ++e) d += QS[r * 65 + e] * KA[key * 65 + e];
              const int dist = 128 + i - key; SC[r * 136 + key] = (dist >= 0 && dist <= 128) ? d * 0.125f - slope * (float)dist : -INFINITY; } } }
    __syncthreads();
    { const int r = tid >> 5, l = tid & 31, g = r >> 2; const float sink = a.in[15][kv * 4 + g];
      float sc[5]; float mx = sink;
#pragma unroll
      for (int jj = 0; jj < 5; ++jj) { const int key = l + 32 * jj; sc[jj] = key < 132 ? SC[r * 136 + key] : -INFINITY; mx = fmaxf(mx, sc[jj]); }
#pragma unroll
      for (int o = 1; o < 32; o <<= 1) mx = fmaxf(mx, __shfl_xor(mx, o));
      float sm = 0.f;
#pragma unroll
      for (int jj = 0; jj < 5; ++jj) { sc[jj] = expf(sc[jj] - mx); sm += sc[jj]; }
#pragma unroll
      for (int o = 1; o < 32; o <<= 1) sm += __shfl_xor(sm, o);
      const float inv = 1.f / (sm + expf(sink - mx));
#pragma unroll
      for (int jj = 0; jj < 5; ++jj) { const int key = l + 32 * jj; if (key < 132) SC[r * 136 + key] = sc[jj] * inv; } }
    __syncthreads();
    { const int r = tid >> 5, d = (tid & 31) * 2, g = r >> 2, i = r & 3; float o0 = 0.f, o1 = 0.f;
#pragma unroll 12
      for (int s = 0; s < 132; ++s) { const float p = SC[r * 136 + s]; o0 += p * VA[s * 65 + d]; o1 += p * VA[s * 65 + d + 1]; }
      float* op = ATTS + (size_t)(b * 4 + i) * 512 + (kv * 4 + g) * 64 + d; op[0] = o0; op[1] = o1; }
    __syncthreads();
}
__device__ __forceinline__ void swa_sample_norm(const Args& a, int lane, int wave) {
    unsigned char* ws = a.ws; const float* ATTS = (const float*)(ws + WS_ATTS); bf16* YMIX = (bf16*)(ws + WS_ACTA);
    const int gw = blockIdx.x * NWAVES + wave, NGW = gridDim.x * NWAVES;
    for (int r = gw; r < MS; r += NGW) {
        const f32x4 v0 = *(const f32x4*)(ATTS + (size_t)r * 512 + 8 * lane), v1 = *(const f32x4*)(ATTS + (size_t)r * 512 + 8 * lane + 4);
        const float ss = wave_sum((v0[0] * v0[0] + v0[1] * v0[1]) + (v0[2] * v0[2] + v0[3] * v0[3]) + (v1[0] * v1[0] + v1[1] * v1[1]) + (v1[2] * v1[2] + v1[3] * v1[3]));
        const float rn = 1.f / sqrtf(ss * (1.f / 512.f) + EPS);
        const f32x4 g0 = *(const f32x4*)(a.in[16] + 8 * lane), g1 = *(const f32x4*)(a.in[16] + 8 * lane + 4);
        u32x4 o; o.x = pk2(v0[0] * rn * g0[0], v0[1] * rn * g0[1]); o.y = pk2(v0[2] * rn * g0[2], v0[3] * rn * g0[3]); o.z = pk2(v1[0] * rn * g1[0], v1[1] * rn * g1[1]); o.w = pk2(v1[2] * rn * g1[2], v1[3] * rn * g1[3]);
        *(u32x4*)(YMIX + (size_t)(MP + r) * DM + 512 + 8 * lane) = o;
    }
}

__device__ __forceinline__ void misc_outputs(const Args& a, int tid) {
    const bf16* Z = (const bf16*)(a.ws + WS_Z);
    const int gt = blockIdx.x * NTHR + tid, NT = gridDim.x * NTHR;
    for (int i = gt; i < 2 * 128 * 128; i += NT) { const int b = i >> 14, j = (i >> 7) & 127, cidx = i & 127; const size_t zr = (size_t)(b * SEQ + SEQ - 128 + j) * NZ;
        a.out[O_KP + i] = bf2f(Z[zr + ZKA + cidx]); a.out[O_VP + i] = bf2f(Z[zr + ZVA + cidx]); }
    for (int i = gt; i < 2 * 3 * 512; i += NT) { const int b = i / 1536, j = (i / 512) % 3, cidx = i & 511;
        a.out[O_CONVP + i] = bf2f(Z[(size_t)(b * SEQ + SEQ - 3 + j) * NZ + ZQK + cidx]); }
}

__device__ __forceinline__ bf16* d1_row(unsigned char* ws, int m) { return m < MP ? (bf16*)(ws + WS_D1P) + (size_t)m * DM : (bf16*)(ws + WS_D1S) + (size_t)(m - MP) * DM; }
__device__ __forceinline__ void rowpass_mix(const Args& a, int lane, int wave) {
    unsigned char* ws = a.ws; const bf16* MIXS = (const bf16*)(ws + WS_MIXS); bf16* U = (bf16*)(ws + WS_ACTA);
    const int gw = blockIdx.x * NWAVES + wave, NGW = gridDim.x * NWAVES;
    f32x4 gp[4], gf[4];
#pragma unroll
    for (int j = 0; j < 2; ++j) { const int c0 = 8 * lane + 512 * j; gp[2 * j] = *(const f32x4*)(a.in[18] + c0); gp[2 * j + 1] = *(const f32x4*)(a.in[18] + c0 + 4); gf[2 * j] = *(const f32x4*)(a.in[19] + c0); gf[2 * j + 1] = *(const f32x4*)(a.in[19] + c0 + 4); }
    for (int grp = MP / 4 + gw; grp < MT / 4; grp += NGW) {
        u32x4 mw[4][2]; f32x4 xv[4][4];
#pragma unroll
        for (int r = 0; r < 4; ++r) { const int m = grp * 4 + r; const float* xr = m < MP ? a.in[0] + (size_t)m * DM : a.in[1] + (size_t)(m - MP) * DM;
#pragma unroll
            for (int j = 0; j < 2; ++j) { const int c0 = 8 * lane + 512 * j; mw[r][j] = *(const u32x4*)(MIXS + (size_t)(m - MP) * DM + c0); xv[r][2 * j] = *(const f32x4*)(xr + c0); xv[r][2 * j + 1] = *(const f32x4*)(xr + c0 + 4); } }
#pragma unroll
        for (int r = 0; r < 4; ++r) { const int m = grp * 4 + r;
            f32x4 mv[4]; float s = 0.f;
#pragma unroll
            for (int j = 0; j < 2; ++j) { mv[2 * j] = (f32x4){bflo(mw[r][j][0]), bfhi(mw[r][j][0]), bflo(mw[r][j][1]), bfhi(mw[r][j][1])}; mv[2 * j + 1] = (f32x4){bflo(mw[r][j][2]), bfhi(mw[r][j][2]), bflo(mw[r][j][3]), bfhi(mw[r][j][3])}; }
#pragma unroll
            for (int q = 0; q < 4; ++q) s += (mv[q][0] * mv[q][0] + mv[q][1] * mv[q][1]) + (mv[q][2] * mv[q][2] + mv[q][3] * mv[q][3]);
            const float rs = 1.f / sqrtf(wave_sum(s) * (1.f / DM) + EPS);
            float s1 = 0.f;
#pragma unroll
            for (int q = 0; q < 4; ++q) { mv[q] = mv[q] * gp[q] * rs; xv[r][q] = xv[r][q] + mv[q]; s1 += (xv[r][q][0] * xv[r][q][0] + xv[r][q][1] * xv[r][q][1]) + (xv[r][q][2] * xv[r][q][2] + xv[r][q][3] * xv[r][q][3]); }
            const float rs1 = 1.f / sqrtf(wave_sum(s1) * (1.f / DM) + EPS);
#pragma unroll
            for (int j = 0; j < 2; ++j) { const int c0 = 8 * lane + 512 * j;
                { u32x4 dd; dd.x = pk2(xv[r][2 * j][0], xv[r][2 * j][1]); dd.y = pk2(xv[r][2 * j][2], xv[r][2 * j][3]); dd.z = pk2(xv[r][2 * j + 1][0], xv[r][2 * j + 1][1]); dd.w = pk2(xv[r][2 * j + 1][2], xv[r][2 * j + 1][3]);
                  *(u32x4*)(d1_row(ws, m) + c0) = dd; }
                const f32x4 u0 = xv[r][2 * j] * gf[2 * j] * rs1, u1 = xv[r][2 * j + 1] * gf[2 * j + 1] * rs1;
                u32x4 o; o.x = pk2(u0[0], u0[1]); o.y = pk2(u0[2], u0[3]); o.z = pk2(u1[0], u1[1]); o.w = pk2(u1[2], u1[3]);
                *(u32x4*)(U + (size_t)m * DM + c0) = o; }
        }
    }
}
__device__ __forceinline__ void rowpass_ffn(const Args& a, int lane, int wave) {
    unsigned char* ws = a.ws; bf16* Fb = (bf16*)(ws + WS_ACTA);
    const int gw = blockIdx.x * NWAVES + wave, NGW = gridDim.x * NWAVES;
    f32x4 gp[4];
#pragma unroll
    for (int j = 0; j < 2; ++j) { const int c0 = 8 * lane + 512 * j; gp[2 * j] = *(const f32x4*)(a.in[22] + c0); gp[2 * j + 1] = *(const f32x4*)(a.in[22] + c0 + 4); }
    for (int grp = MP / 4 + gw; grp < MT / 4; grp += NGW) {
        u32x4 fw[4][2], dw[4][2];
#pragma unroll
        for (int r = 0; r < 4; ++r) { const int m = grp * 4 + r; const bf16* dr = d1_row(ws, m);
#pragma unroll
            for (int j = 0; j < 2; ++j) { const int c0 = 8 * lane + 512 * j; fw[r][j] = *(const u32x4*)(Fb + (size_t)m * DM + c0); dw[r][j] = *(const u32x4*)(dr + c0); } }
#pragma unroll
        for (int r = 0; r < 4; ++r) { const int m = grp * 4 + r;
            f32x4 fv[4]; float s = 0.f;
#pragma unroll
            for (int j = 0; j < 2; ++j) { fv[2 * j] = (f32x4){bflo(fw[r][j][0]), bfhi(fw[r][j][0]), bflo(fw[r][j][1]), bfhi(fw[r][j][1])}; fv[2 * j + 1] = (f32x4){bflo(fw[r][j][2]), bfhi(fw[r][j][2]), bflo(fw[r][j][3]), bfhi(fw[r][j][3])}; }
#pragma unroll
            for (int q = 0; q < 4; ++q) s += (fv[q][0] * fv[q][0] + fv[q][1] * fv[q][1]) + (fv[q][2] * fv[q][2] + fv[q][3] * fv[q][3]);
            const float rs = 1.f / sqrtf(wave_sum(s) * (1.f / DM) + EPS);
#pragma unroll
            for (int j = 0; j < 2; ++j) { const int c0 = 8 * lane + 512 * j;
                const f32x4 d0 = {bflo(dw[r][j][0]), bfhi(dw[r][j][0]), bflo(dw[r][j][1]), bfhi(dw[r][j][1])}, d1 = {bflo(dw[r][j][2]), bfhi(dw[r][j][2]), bflo(dw[r][j][3]), bfhi(dw[r][j][3])};
                const f32x4 x0 = d0 + fv[2 * j] * gp[2 * j] * rs, x1 = d1 + fv[2 * j + 1] * gp[2 * j + 1] * rs;
                u32x4 o; o.x = pk2(x0[0], x0[1]); o.y = pk2(x0[2], x0[3]); o.z = pk2(x1[0], x1[1]); o.w = pk2(x1[2], x1[3]);
                *(u32x4*)((bf16*)(ws + WS_X2) + (size_t)m * DM + c0) = o; }
        }
    }
}
struct SkBf16 { bf16* O; int ldc; int act;
    __device__ __forceinline__ void operator()(int row, int col, f32x4 v) const {
        if (act == 2) {
#pragma unroll
            for (int e = 0; e < 4; ++e) { const float t = v[e] > 0.f ? v[e] : 0.f; v[e] = t * t; } }
        u32x2 o; o.x = pk2(v[0], v[1]); o.y = pk2(v[2], v[3]); *(u32x2*)(O + (size_t)row * ldc + col) = o; } };
struct SkFinal { float* out; const bf16* PP; const bf16* X2;
    __device__ __forceinline__ void operator()(int row, int col, f32x4 v) const {
        const size_t o = (size_t)row * DM + col; const u32x2 xw = *(const u32x2*)(X2 + o); const f32x4 xs = {bflo(xw.x), bfhi(xw.x), bflo(xw.y), bfhi(xw.y)}; const u32x2 pw = *(const u32x2*)(PP + o);
        f32x4 r; r[0] = xs[0] + bflo(pw.x) * sigmoidf_(v[0]); r[1] = xs[1] + bfhi(pw.x) * sigmoidf_(v[1]); r[2] = xs[2] + bflo(pw.y) * sigmoidf_(v[2]); r[3] = xs[3] + bfhi(pw.y) * sigmoidf_(v[3]);
        *(f32x4*)(out + o) = r; } };
struct SkNormX { float* xbuf; unsigned* cnt; const bf16* X1; const float* g; bf16* X2; };
__device__ __forceinline__ void skinny_norm_epilogue(const SkNormX& nx, LAS float* SSQ  , LAS float* RS  , int r0, int c0, int rloc, int col, f32x4 v, int tid, int lane, int wave) {
    const int rb = r0 >> 6, cb = c0 >> 5;
    SSQ[128 + rloc * 8 + (((col - c0) >> 2) & 7)] = (v[0] * v[0] + v[1] * v[1]) + (v[2] * v[2] + v[3] * v[3]);
    __syncthreads();
    if (tid < 64) { const LAS float* pp = SSQ + 128 + tid * 8; const float t = ((pp[0] + pp[1]) + (pp[2] + pp[3])) + ((pp[4] + pp[5]) + (pp[6] + pp[7]));
        __hip_atomic_store(nx.xbuf + ((size_t)(rb * 64 + tid) * 32 + cb), t, __ATOMIC_RELAXED, __HIP_MEMORY_SCOPE_AGENT); }
    if (wave == 0) { asm volatile("s_waitcnt vmcnt(0)" ::: "memory");
        if (lane == 0) __hip_atomic_fetch_add(nx.cnt + 64 * rb, 1u, __ATOMIC_RELAXED, __HIP_MEMORY_SCOPE_AGENT);
        unsigned sp = 0u;
        for (;;) { if ((unsigned)__builtin_amdgcn_readfirstlane(__hip_atomic_load(nx.cnt + 64 * rb, __ATOMIC_RELAXED, __HIP_MEMORY_SCOPE_AGENT)) >= 32u) break;
            if (++sp > (1u << 21)) break;
            __builtin_amdgcn_s_sleep(2); }
        __builtin_amdgcn_fence(__ATOMIC_ACQUIRE, "agent"); }
    asm volatile("s_waitcnt vmcnt(0) lgkmcnt(0)" ::: "memory"); __syncthreads();
    { const int row = tid >> 3, part = tid & 7; const float* slot = nx.xbuf + (size_t)(rb * 64 + row) * 32 + part * 4; float t = 0.f;
#pragma unroll
      for (int q = 0; q < 4; ++q) t += __hip_atomic_load(slot + q, __ATOMIC_RELAXED, __HIP_MEMORY_SCOPE_AGENT);
      t += __shfl_xor(t, 1); t += __shfl_xor(t, 2); t += __shfl_xor(t, 4);
      if (part == 0) RS[row] = 1.f / sqrtf(t * (1.f / 1024.f) + EPS); }
    __syncthreads();
    const float rs = RS[rloc];
    const size_t o = (size_t)(r0 + rloc) * DM + col; const u32x2 xw = *(const u32x2*)(nx.X1 + o); const f32x4 g4 = *(const f32x4*)(nx.g + col);
    u32x2 w; w.x = pk2(bflo(xw.x) + v[0] * rs * g4[0], bfhi(xw.x) + v[1] * rs * g4[1]); w.y = pk2(bflo(xw.y) + v[2] * rs * g4[2], bfhi(xw.y) + v[3] * rs * g4[3]);
    *(u32x2*)(nx.X2 + o) = w;
}
template <int KC, class Epi>
__device__ __forceinline__ void skinny_gemm(LAS unsigned char* lds, const bf16* A, const bf16* Bt, int N, int K, const Epi& E, int tid, int lane, int wave, int first = -1, int stride = 0) {
    constexpr int PITCH = KC * 2 + 16, APC = KC / 8, NA = 64 * APC / NTHR, NB = 32 * APC / NTHR, STEPS = KC / 128;
    LAS unsigned char* AS = lds; LAS unsigned char* BS = lds + 64 * PITCH;
    LAS float* PART = (LAS float*)lds;
    const int ntiles = 8 * (N / 32), l32 = lane & 31, hi = lane >> 5, nch = K / KC;
    if (first < 0) { first = blockIdx.x; stride = gridDim.x; }
    for (int tile = first; tile < ntiles; tile += stride) {
        int r0 = (tile & 7) * 64, c0 = (tile >> 3) * 32;
        if (stride == 256) { const int bxx = tile & 255, it = tile >> 8; r0 = ((bxx >> 3) & 7) * 64; c0 = (it * 32 + (bxx >> 6) * 8 + (bxx & 7)) * 32; }
        f32x16 acc0 = {}, acc1 = {};
        u32x4 ra[NA], rb[NB];
#define SK_LOADG(chk) do { \
        _Pragma("unroll") for (int i = 0; i < NA; ++i) { const int p = tid + NTHR * i, row = p / APC, pc = p % APC; ra[i] = *(const u32x4*)(A + (size_t)(r0 + row) * K + (chk) * KC + pc * 8); } \
        _Pragma("unroll") for (int i = 0; i < NB; ++i) { const int p = tid + NTHR * i, row = p / APC, pc = p % APC; rb[i] = *(const u32x4*)(Bt + (size_t)(c0 + row) * K + (chk) * KC + pc * 8); } } while (0)
        SK_LOADG(0);
        for (int ch = 0; ch < nch; ++ch) {
#pragma unroll
            for (int i = 0; i < NA; ++i) { const int p = tid + NTHR * i, row = p / APC, pc = p % APC; *(LAS u32x4*)(AS + row * PITCH + pc * 16) = ra[i]; }
#pragma unroll
            for (int i = 0; i < NB; ++i) { const int p = tid + NTHR * i, row = p / APC, pc = p % APC; *(LAS u32x4*)(BS + row * PITCH + pc * 16) = rb[i]; }
            if (ch + 1 < nch) SK_LOADG(ch + 1);
            __syncthreads();
#pragma unroll
            for (int s = 0; s < STEPS; ++s) { const int koff = (wave * (KC / 8) + s * 16 + 8 * hi) * 2;
                const bf16x8 b = *(const LAS bf16x8*)(BS + l32 * PITCH + koff), a0 = *(const LAS bf16x8*)(AS + l32 * PITCH + koff), a1 = *(const LAS bf16x8*)(AS + (32 + l32) * PITCH + koff);
                acc0 = __builtin_amdgcn_mfma_f32_32x32x16_bf16(b, a0, acc0, 0, 0, 0); acc1 = __builtin_amdgcn_mfma_f32_32x32x16_bf16(b, a1, acc1, 0, 0, 0); }
            __syncthreads();
        }
#undef SK_LOADG
#pragma unroll
        for (int r = 0; r < 16; ++r) { PART[((wave * 2 + 0) * 16 + r) * 64 + lane] = acc0[r]; PART[((wave * 2 + 1) * 16 + r) * 64 + lane] = acc1[r]; }
        __syncthreads();
        { const int i = tid >> 8, rq = (tid >> 6) & 3, ln = tid & 63; f32x4 v = {0.f, 0.f, 0.f, 0.f};
#pragma unroll
          for (int w = 0; w < 8; ++w)
#pragma unroll
              for (int e = 0; e < 4; ++e) v[e] += PART[((w * 2 + i) * 16 + 4 * rq + e) * 64 + ln];
          if constexpr (__is_same(Epi, SkNormX)) { LAS float* SSQ = (LAS float*)(lds + 65536); LAS float* RS = SSQ + 64;
              skinny_norm_epilogue(E, SSQ, RS, r0, c0, 32 * i + (ln & 31), c0 + 8 * rq + 4 * (ln >> 5), v, tid, lane, wave); }
          else E(r0 + 32 * i + (ln & 31), c0 + 8 * rq + 4 * (ln >> 5), v); }
        __syncthreads();
    }
}

template <class Epi>
__device__ __forceinline__ void skinny_gemm128(LAS unsigned char* lds, const bf16* A, const bf16* Bt, int N, int K, const Epi& E, int tid, int lane, int wave, int first = -1, int stride = 0) {
    constexpr int KC = 256, PITCH = KC * 2 + 16, APC = KC / 8, NA = 128 * APC / NTHR, NB = 64 * APC / NTHR;
    LAS unsigned char* AS = lds; LAS unsigned char* BS = lds + 128 * PITCH;
    const int ntiles = 4 * (N / 64), l32 = lane & 31, hi = lane >> 5, nch = K / KC, rbk = wave >> 1, cbk = wave & 1;
    if (first < 0) { first = blockIdx.x; stride = gridDim.x; }
    for (int tile = first; tile < ntiles; tile += stride) {
        const int r0 = (tile & 3) * 128, c0 = (tile >> 2) * 64;
        f32x16 acc = {};
        u32x4 ra[NA], rb[NB];
#define SK_LOADG(chk) do { \
        _Pragma("unroll") for (int i = 0; i < NA; ++i) { const int p = tid + NTHR * i, row = p / APC, pc = p % APC; ra[i] = *(const u32x4*)(A + (size_t)(r0 + row) * K + (chk) * KC + pc * 8); } \
        _Pragma("unroll") for (int i = 0; i < NB; ++i) { const int p = tid + NTHR * i, row = p / APC, pc = p % APC; rb[i] = *(const u32x4*)(Bt + (size_t)(c0 + row) * K + (chk) * KC + pc * 8); } } while (0)
        SK_LOADG(0);
        for (int ch = 0; ch < nch; ++ch) {
#pragma unroll
            for (int i = 0; i < NA; ++i) { const int p = tid + NTHR * i, row = p / APC, pc = p % APC; *(LAS u32x4*)(AS + row * PITCH + pc * 16) = ra[i]; }
#pragma unroll
            for (int i = 0; i < NB; ++i) { const int p = tid + NTHR * i, row = p / APC, pc = p % APC; *(LAS u32x4*)(BS + row * PITCH + pc * 16) = rb[i]; }
            if (ch + 1 < nch) SK_LOADG(ch + 1);
            __syncthreads();
#pragma unroll
            for (int s = 0; s < KC / 16; ++s) { const int koff = (s * 16 + 8 * hi) * 2;
                const bf16x8 b = *(const LAS bf16x8*)(BS + (cbk * 32 + l32) * PITCH + koff), a = *(const LAS bf16x8*)(AS + (rbk * 32 + l32) * PITCH + koff);
                acc = __builtin_amdgcn_mfma_f32_32x32x16_bf16(b, a, acc, 0, 0, 0); }
            __syncthreads();
        }
#undef SK_LOADG
#pragma unroll
        for (int rg = 0; rg < 4; ++rg) E(r0 + rbk * 32 + l32, c0 + cbk * 32 + 8 * rg + 4 * hi, (f32x4){acc[4 * rg], acc[4 * rg + 1], acc[4 * rg + 2], acc[4 * rg + 3]});
    }
}
constexpr int N_PHASES = 11;
__global__ void __launch_bounds__(NTHR) hymba_fwd(Args args) {
    extern __shared__ __attribute__((aligned(16))) unsigned char lds_raw[];
    LAS unsigned char* lds = (LAS unsigned char*)lds_raw;
    const int tid = threadIdx.x, lane = tid & 63, wave = __builtin_amdgcn_readfirstlane(tid >> 6);
    const int G = gridDim.x, bx = blockIdx.x;
    unsigned char* ws = args.ws;
    const int lo = args.ph_lo, hi = args.ph_hi;
#ifndef PHMASK
#define PHMASK 0x7ff
#endif
#define IN(k) (((PHMASK >> (k)) & 1) && lo <= (k) && (k) < hi)
    if (tid < 256) ((LAS unsigned*)(lds + 131072))[tid] = 0u;
    __syncthreads();
    XcdBarrier bar; bar.bar = (unsigned*)(ws + WS_CTL); bar.x = 0; bar.st = nullptr;
    if (args.coop) bar = xcd_barrier_post((unsigned*)(ws + WS_CTL), (volatile LAS unsigned*)(lds + MISC_OFF) + 8);
    if (args.pad == 0x5a5a) cg::this_grid().sync();
#define SEAM(k) do { if (args.coop && IN((k) + 1)) { xcd_barrier(bar); } } while (0)
    bf16* ACTA = (bf16*)(ws + WS_ACTA);
    if (IN(0)) { p0_prologue(args, lds, tid, lane, wave); SEAM(0); }
    if (IN(1)) {
        const int skf = (G == 256) ? (bx >= 64 ? bx - 64 : (1 << 28)) : bx, sks = (G == 256) ? 192 : G;
        { SkBf16 E{(bf16*)(ws + WS_Z) + (size_t)MP * NZ, NZ, 0}; skinny_gemm<512>(lds, ACTA + (size_t)MP * DM, (const bf16*)(ws + WS_WIN), NZ, DM, E, tid, lane, wave, skf, sks); }
        { SkBf16 E{(bf16*)(ws + WS_PP) + (size_t)MP * DM, DM, 0}; skinny_gemm<256>(lds, (const bf16*)(ws + WS_PBF) + (size_t)MP * PD, (const bf16*)(ws + WS_WPP), DM, PD, E, tid, lane, wave, skf, sks); }
        { pg8::Gemm g{ACTA, (const bf16*)(ws + WS_WIN), MP, NZ, DM}; pg8::StaticOrder S; S.init(MP, NZ, G, bx);
          pg8::EpiBf16<0> E{(bf16*)(ws + WS_Z), NZ};
          pg8::gemm_phase<pg8::EpiBf16<0>, pg8::StaticOrder, true, true>(lds, g, S, E); }
        { pg8::Gemm g{(const bf16*)(ws + WS_PBF), (const bf16*)(ws + WS_WPP), MP, DM, PD}; pg8::StaticOrder S; S.init(MP, DM, 192, bx >= 64 ? bx - 64 : 1 << 20);
          pg8::EpiBf16<0> E{(bf16*)(ws + WS_PP), DM};
          pg8::gemm_phase<pg8::EpiBf16<0>, pg8::StaticOrder, true, true>(lds, g, S, E); }
        SEAM(1);
    }
    if (IN(2)) {
        if (G == 256) {
            float cs0[16], cs1[16]; f32x4 kq[4], vq[4];
            mlstm_sample_prefetch(args, bx, tid, cs0); mlstm_sample_prefetch(args, bx + 256, tid, cs1); swa_sample_prefetch(args, bx, tid, kq, vq);
            mlstm_b1_unit(args, lds, bx, tid, lane, wave); mlstm_b1_unit(args, lds, bx + 256, tid, lane, wave);
            mlstm_sample_unit(args, lds, bx, tid, lane, wave, cs0); mlstm_sample_unit(args, lds, bx + 256, tid, lane, wave, cs1);
            swa_sample_unit(args, lds, bx, tid, lane, wave, kq, vq);
        } else {
            for (int u = bx; u < 512; u += G) mlstm_b1_unit(args, lds, u, tid, lane, wave);
            for (int u = bx; u < 512; u += G) { float cs0[16]; mlstm_sample_prefetch(args, u, tid, cs0); mlstm_sample_unit(args, lds, u, tid, lane, wave, cs0); }
            for (int u = bx; u < 256; u += G) { f32x4 kq[4], vq[4]; swa_sample_prefetch(args, u, tid, kq, vq); swa_sample_unit(args, lds, u, tid, lane, wave, kq, vq); }
        }
        SEAM(2);
    }
    if (IN(3)) {
        if (!(args.pad & 1)) mlstm_scan(args, tid);
        if (bx >= 129) { transpose_items(args, lds, IT_EARLY, IT_ALL, (bx - 129) * NWAVES + wave, (G - 129) * NWAVES, lane, wave); __syncthreads(); }
        if (!(args.pad & 2)) {
            if (G == 256) {
                const int vcu = (bx & 7) * 32 + (bx >> 3);
                swa_prompt_unit(args, lds, vcu, tid, lane, wave);
            } else for (int u = bx; u < 256; u += G) swa_prompt_unit(args, lds, u, tid, lane, wave);
        }
        if (!(args.pad & 4)) { misc_outputs(args, tid); swa_sample_norm(args, lane, wave); }
        SEAM(3);
    }
    if (IN(4)) {
        for (int u = 2 * bx; u < 512; u += 2 * G) mlstm_b3_pair(args, lds, u, tid, lane, wave);
        { SkBf16 E{(bf16*)(ws + WS_MIXS), DM, 0}; skinny_gemm<512>(lds, ACTA + (size_t)MP * DM, (const bf16*)(ws + WS_WOUT), DM, DM, E, tid, lane, wave); }
        SEAM(4);
    }
    if (IN(5)) {
        rowpass_mix(args, lane, wave);
        pg8::Gemm g{ACTA, (const bf16*)(ws + WS_WOUT), MP, DM, DM}; pg8::StaticOrder S; S.init(MP, DM, G, bx);
        unsigned* cb = (unsigned*)(ws + WS_CTL + 16384); float* xb = (float*)(ws + WS_XBUF);
        pg8::EpiMixNorm E{args.in[18], args.in[19], (bf16*)(ws + WS_D1P), ACTA, DM, EPS, pg8::RowSumSq{xb, cb}, pg8::RowSumSq{xb + 65536, cb + 4096}};
        pg8::gemm_phase<pg8::EpiMixNorm, pg8::StaticOrder, false, true>(lds, g, S, E);
        SEAM(6);
    }
    if (IN(7)) {
        { SkBf16 E2{(bf16*)(ws + WS_H) + (size_t)MP * FF, FF, 2}; skinny_gemm128(lds, ACTA + (size_t)MP * DM, (const bf16*)(ws + WS_WUP), FF, DM, E2, tid, lane, wave); }
        pg8::Gemm g{ACTA, (const bf16*)(ws + WS_WUP), MP, FF, DM}; pg8::StaticOrder S; S.init(MP, FF, G, bx);
        pg8::EpiBf16<2> E{(bf16*)(ws + WS_H), FF};
        pg8::gemm_phase<pg8::EpiBf16<2>, pg8::StaticOrder, true, true>(lds, g, S, E);
        SEAM(7);
    }
    if (IN(8)) {
        { SkNormX E2{(float*)(ws + WS_XBUF) + 196608, (unsigned*)(ws + WS_CTL + 16384) + 12288, (const bf16*)(ws + WS_D1S), args.in[22], ACTA + (size_t)MP * DM};
          skinny_gemm<512>(lds, (const bf16*)(ws + WS_H) + (size_t)MP * FF, (const bf16*)(ws + WS_WDN), DM, FF, E2, tid, lane, wave); }
        pg8::Gemm g{(const bf16*)(ws + WS_H), (const bf16*)(ws + WS_WDN), MP, DM, FF}; pg8::StaticOrder S; S.init(MP, DM, G, bx);
        pg8::EpiFfnNorm E{(const bf16*)(ws + WS_D1P), args.in[22], ACTA, DM, EPS, pg8::RowSumSq{(float*)(ws + WS_XBUF) + 131072, (unsigned*)(ws + WS_CTL + 16384) + 8192}};
        pg8::gemm_phase<pg8::EpiFfnNorm, pg8::StaticOrder, false, true>(lds, g, S, E);
        SEAM(9);
    }
    if (IN(10)) {
        const bf16* X2 = ACTA;
        { SkFinal E{args.out + (size_t)MP * DM, (const bf16*)(ws + WS_PP) + (size_t)MP * DM, X2 + (size_t)MP * DM}; skinny_gemm<512>(lds, X2 + (size_t)MP * DM, (const bf16*)(ws + WS_WPG), DM, DM, E, tid, lane, wave); }
        pg8::Gemm g{X2, (const bf16*)(ws + WS_WPG), MP, DM, DM}; pg8::StaticOrder S; S.init(MP, DM, G, bx);
        pg8::EpiFinal E{args.out, (const bf16*)(ws + WS_PP), X2, DM};
        pg8::gemm_phase<pg8::EpiFinal, pg8::StaticOrder, true, true>(lds, g, S, E);
    }
#undef IN
#undef SEAM
}

#ifndef REP_MASK
#define REP_MASK 0
#endif
#ifndef REP_SKIP
#define REP_SKIP 0
#endif
#ifndef MK_SINGLE
#define MK_SINGLE 1
#endif
extern "C" void kernel_launch(void* const* d_in, const int* in_sizes, int n_in, void* d_out, int out_size, void* d_ws, size_t ws_size, hipStream_t stream) {
    static int grid = 0;
    if (grid == 0) {
        if (n_in != 25 || out_size != (int)O_END || ws_size < WS_END) { fprintf(stderr, "kernel_launch: unexpected shapes: n_in %d out %d ws %zu\n", n_in, out_size, ws_size); grid = -1; return; }
        int dev = 0, cus = 0, per_cu = 0;
        hipGetDevice(&dev); hipDeviceGetAttribute(&cus, hipDeviceAttributeMultiprocessorCount, dev);
        if (hipFuncSetAttribute((const void*)hymba_fwd, hipFuncAttributeMaxDynamicSharedMemorySize, LDS_BYTES) != hipSuccess) { fprintf(stderr, "kernel_launch: hipFuncSetAttribute failed\n"); grid = -1; return; }
        hipOccupancyMaxActiveBlocksPerMultiprocessor(&per_cu, (const void*)hymba_fwd, NTHR, LDS_BYTES);
        (void)hipGetLastError();
        if (per_cu < 1) per_cu = 1;
        grid = cus * 1;
        fprintf(stderr, "kernel_launch: cus %d per_cu %d grid %d\n", cus, per_cu, grid);
    }
    if (grid < 0) return;
    if (hipMemsetAsync((char*)d_ws + WS_CTL, 0, CTL_BYTES, stream) != hipSuccess) { fprintf(stderr, "kernel_launch: memset failed\n"); return; }
    Args a{};
    for (int i = 0; i < 25; ++i) a.in[i] = (const float*)d_in[i];
    a.out = (float*)d_out; a.ws = (unsigned char*)d_ws;
#if MK_SINGLE
    a.ph_lo = 0; a.ph_hi = N_PHASES; a.coop = 1;
    void* kargs[] = {&a};
    hipError_t e = hipLaunchCooperativeKernel((const void*)hymba_fwd, dim3(grid), dim3(NTHR), kargs, LDS_BYTES, stream);
    if (e != hipSuccess) fprintf(stderr, "cooperative launch failed: %s (grid %d)\n", hipGetErrorString(e), grid);
#else
    for (int p = 0; p < N_PHASES; ++p) { a.ph_lo = p; a.ph_hi = p + 1; a.coop = 0;
        for (int r = 0; r < (((REP_MASK >> p) & 1) ? 2 : 1); ++r) { a.pad = r ? REP_SKIP : 0; hipLaunchKernelGGL(hymba_fwd, dim3(grid), dim3(NTHR), LDS_BYTES, stream, a); } }
#endif
}
```
